# Optimizing an MI355X kernel written in HIP

```python
import jax, jax.numpy as jnp
from jax import lax
import numpy as np

D_MODEL = 2048
BATCH = 4
SEQ = 8192
DEPTH = 1

MEM_LEN = 256
ROPE_THETA = 500000.0
EPS = 1e-6
Q_BLOCK = 128
NEG = -1e30

NSA_HEADS = 16
NSA_KV_HEADS = 4
NSA_HPG = NSA_HEADS // NSA_KV_HEADS
NSA_DK = 96
NSA_DV = 64
NSA_ROT = NSA_DK // 4
CMP_BLOCK = 32
CMP_STRIDE = 16
SEL_BLOCK = 64
SEL_TOPK = 16
WINDOW = 512

MLA_HEADS = 16
MLA_NOPE = 64
MLA_ROPE = 32
MLA_DV = 64
MLA_Q_RANK = 512
MLA_KV_RANK = 256

XA_HEADS = 4
XA_DIM = 128

D_FF = 4 * D_MODEL

SPLITS = (NSA_HEADS * NSA_DK,
          NSA_KV_HEADS * NSA_DK, NSA_KV_HEADS * NSA_DV,
          NSA_KV_HEADS * NSA_DK, NSA_KV_HEADS * NSA_DV,
          NSA_KV_HEADS * NSA_DK, NSA_KV_HEADS * NSA_DV,
          NSA_HEADS * 3,
          MLA_Q_RANK, MLA_KV_RANK, MLA_ROPE,
          D_MODEL, D_MODEL)
D_IN = (NSA_HEADS * NSA_DK + 3 * NSA_KV_HEADS * (NSA_DK + NSA_DV) + NSA_HEADS * 3
        + MLA_Q_RANK + MLA_KV_RANK + MLA_ROPE + 2 * D_MODEL)

kernel_name = 'hybrid_nsa_mla_gated_block'


def rmsnorm(x, g):
    xf = x.astype(jnp.float32)
    y = xf * lax.rsqrt(jnp.mean(xf * xf, axis=-1, keepdims=True) + EPS)
    return (y * g.astype(jnp.float32)).astype(x.dtype)


def rope_tables(n_pos, dim):
    inv = 1.0 / (ROPE_THETA ** (jnp.arange(0, dim, 2, dtype=jnp.float32) / dim))
    ang = jnp.arange(n_pos, dtype=jnp.float32)[:, None] * inv[None, :]
    return jnp.cos(ang), jnp.sin(ang)


def apply_rope(x, cos, sin):
    half = x.shape[-1] // 2
    shp = (cos.shape[0],) + (1,) * (x.ndim - 3) + (half,)
    c, s = cos.reshape(shp), sin.reshape(shp)
    xf = x.astype(jnp.float32)
    x1, x2 = xf[..., :half], xf[..., half:]
    return jnp.concatenate([x1 * c - x2 * s, x1 * s + x2 * c], axis=-1).astype(x.dtype)


def partial_rope(x, cos, sin):
    return jnp.concatenate([apply_rope(x[..., :NSA_ROT], cos, sin), x[..., NSA_ROT:]], axis=-1)


def masked_softmax(s, mask):
    s = jnp.where(mask, s.astype(jnp.float32), NEG)
    m = jnp.max(s, axis=-1, keepdims=True)
    e = jnp.where(mask, jnp.exp(s - m), 0.0)
    return e / jnp.maximum(jnp.sum(e, axis=-1, keepdims=True), 1e-30)


def compress(kv, pos, w1, w2):
    b, s, g, d = kv.shape
    nc = (s - CMP_BLOCK) // CMP_STRIDE + 1
    idx = (np.arange(nc) * CMP_STRIDE)[:, None] + np.arange(CMP_BLOCK)[None, :]
    blk = kv[:, idx] + pos[None, None, :, None, :].astype(kv.dtype)
    blk = blk.transpose(0, 1, 3, 2, 4).reshape(b, nc, g, CMP_BLOCK * d)
    return jax.nn.gelu(blk @ w1) @ w2


def cmp_to_sel_matrix(nc, nsb):
    cs = np.arange(nc) * CMP_STRIDE
    ce = cs + CMP_BLOCK
    ss = np.arange(nsb) * SEL_BLOCK
    se = ss + SEL_BLOCK
    ov = np.clip(np.minimum(ce[:, None], se[None, :]) - np.maximum(cs[:, None], ss[None, :]), 0, None)
    return jnp.asarray(ov.astype(np.float32) / np.float32(CMP_BLOCK))


def nsa_attention(q, kc, vc, ks, vs, kw, vw, gates,
                  cmp_pos_k, cmp_w1_k, cmp_w2_k, cmp_pos_v, cmp_w1_v, cmp_w2_v):
    b, s = q.shape[:2]
    G, HPG = NSA_KV_HEADS, NSA_HPG
    scale = NSA_DK ** -0.5
    kcc = compress(kc, cmp_pos_k, cmp_w1_k, cmp_w2_k)
    vcc = compress(vc, cmp_pos_v, cmp_w1_v, cmp_w2_v)
    nc = kcc.shape[1]
    cmp_end = jnp.arange(nc) * CMP_STRIDE + CMP_BLOCK - 1
    nsb = s // SEL_BLOCK
    topk = min(SEL_TOPK, nsb)
    m_sel = cmp_to_sel_matrix(nc, nsb)
    ks_blk = ks.reshape(b, nsb, SEL_BLOCK, G, NSA_DK).transpose(0, 3, 1, 2, 4)
    vs_blk = vs.reshape(b, nsb, SEL_BLOCK, G, NSA_DV).transpose(0, 3, 1, 2, 4)
    kw_pad = jnp.pad(kw, ((0, 0), (WINDOW, 0), (0, 0), (0, 0)))
    vw_pad = jnp.pad(vw, ((0, 0), (WINDOW, 0), (0, 0), (0, 0)))
    bi = jnp.arange(b)[:, None, None, None]
    gi = jnp.arange(G)[None, :, None, None]
    blk_ids = jnp.arange(nsb)

    def block(i):
        s0 = i * Q_BLOCK
        t = s0 + jnp.arange(Q_BLOCK)
        qb = lax.dynamic_slice_in_dim(q, s0, Q_BLOCK, axis=1).reshape(b, Q_BLOCK, G, HPG, NSA_DK)
        gb = lax.dynamic_slice_in_dim(gates, s0, Q_BLOCK, axis=1).reshape(b, Q_BLOCK, G, HPG, 3)
        s_c = jnp.einsum('bqghd,bcgd->bghqc', qb, kcc) * scale
        p_c = masked_softmax(s_c, cmp_end[None, :] <= t[:, None])
        o_c = jnp.einsum('bghqc,bcgd->bqghd', p_c.astype(vcc.dtype), vcc)
        imp = jnp.einsum('bghqc,cj->bgqj', p_c, m_sel)
        cur = t // SEL_BLOCK
        valid = blk_ids[None, :] <= cur[:, None]
        forced = (blk_ids[None, :] == 0) | (blk_ids[None, :] == cur[:, None]) | (blk_ids[None, :] == cur[:, None] - 1)
        score = jnp.where(valid, jnp.where(forced, 1e4, imp), -1.0)
        _, sel = lax.top_k(score, topk)
        kg = ks_blk[bi, gi, sel]
        vg = vs_blk[bi, gi, sel]
        kpos = sel[..., None] * SEL_BLOCK + jnp.arange(SEL_BLOCK)
        m_s = (kpos <= t[None, None, :, None, None]).reshape(b, G, 1, Q_BLOCK, topk * SEL_BLOCK)
        s_s = jnp.einsum('bqghd,bgqnrd->bghqnr', qb, kg).reshape(b, G, HPG, Q_BLOCK, topk * SEL_BLOCK) * scale
        p_s = masked_softmax(s_s, m_s).reshape(b, G, HPG, Q_BLOCK, topk, SEL_BLOCK)
        o_s = jnp.einsum('bghqnr,bgqnrd->bqghd', p_s.astype(vg.dtype), vg)
        kwb = lax.dynamic_slice_in_dim(kw_pad, s0, Q_BLOCK + WINDOW, axis=1)
        vwb = lax.dynamic_slice_in_dim(vw_pad, s0, Q_BLOCK + WINDOW, axis=1)
        kp = s0 - WINDOW + jnp.arange(Q_BLOCK + WINDOW)
        diff = t[:, None] - kp[None, :]
        m_w = (kp[None, :] >= 0) & (diff >= 0) & (diff < WINDOW)
        s_w = jnp.einsum('bqghd,bkgd->bghqk', qb, kwb) * scale
        p_w = masked_softmax(s_w, m_w)
        o_w = jnp.einsum('bghqk,bkgd->bqghd', p_w.astype(vwb.dtype), vwb)
        o = gb[..., 0:1] * o_c + gb[..., 1:2] * o_s + gb[..., 2:3] * o_w
        return o.reshape(b, Q_BLOCK, NSA_HEADS * NSA_DV).astype(q.dtype)

    out = lax.map(block, jnp.arange(s // Q_BLOCK))
    return out.transpose(1, 0, 2, 3).reshape(b, s, NSA_HEADS * NSA_DV)


def mla_attention(c_q, c_kv, k_rope, g_q, w_uq, g_kv, w_uk, w_uv, cos, sin):
    b, s = c_q.shape[:2]
    q = (rmsnorm(c_q, g_q) @ w_uq).reshape(b, s, MLA_HEADS, MLA_NOPE + MLA_ROPE)
    q_nope = q[..., :MLA_NOPE]
    q_rope = apply_rope(q[..., MLA_NOPE:], cos, sin)
    ckv = rmsnorm(c_kv, g_kv)
    k_nope = (ckv @ w_uk).reshape(b, s, MLA_HEADS, MLA_NOPE)
    v = (ckv @ w_uv).reshape(b, s, MLA_HEADS, MLA_DV)
    k_r = apply_rope(k_rope, cos, sin)
    scale = (MLA_NOPE + MLA_ROPE) ** -0.5
    kpos = jnp.arange(s)

    def block(i):
        s0 = i * Q_BLOCK
        t = s0 + jnp.arange(Q_BLOCK)
        qn = lax.dynamic_slice_in_dim(q_nope, s0, Q_BLOCK, axis=1)
        qr = lax.dynamic_slice_in_dim(q_rope, s0, Q_BLOCK, axis=1)
        sc = (jnp.einsum('bqhd,bkhd->bhqk', qn, k_nope)
              + jnp.einsum('bqhd,bkd->bhqk', qr, k_r)) * scale
        p = masked_softmax(sc, kpos[None, :] <= t[:, None])
        o = jnp.einsum('bhqk,bkhd->bqhd', p.astype(v.dtype), v)
        return o.reshape(b, Q_BLOCK, MLA_HEADS * MLA_DV).astype(c_q.dtype)

    out = lax.map(block, jnp.arange(s // Q_BLOCK))
    return out.transpose(1, 0, 2, 3).reshape(b, s, MLA_HEADS * MLA_DV)


def memory_cross_attention(xn, memn, wq, wkv, wo):
    b, s = xn.shape[:2]
    m = memn.shape[1]
    q = (xn @ wq).reshape(b, s, XA_HEADS, XA_DIM)
    k, v = jnp.split((memn @ wkv).reshape(m * 0 + b, m, 2, XA_HEADS, XA_DIM), 2, axis=2)
    k, v = k[:, :, 0], v[:, :, 0]
    sc = jnp.einsum('bqhd,bmhd->bhqm', q, k).astype(jnp.float32) * (XA_DIM ** -0.5)
    p = jax.nn.softmax(sc, axis=-1)
    o = jnp.einsum('bhqm,bmhd->bqhd', p.astype(v.dtype), v).reshape(b, s, XA_HEADS * XA_DIM)
    return (o @ wo).astype(xn.dtype)


def setup_inputs(seed: int = 0) -> dict:
    key = jax.random.key(seed)
    ks = jax.random.split(key, 32)
    L = DEPTH

    def nrm(k, shape, scale):
        return jax.random.normal(k, shape, jnp.float32) * scale

    def gain(k, shape):
        return 1.0 + 0.02 * jax.random.normal(k, shape, jnp.float32)

    return {
        "x": nrm(ks[0], (BATCH, SEQ, D_MODEL), 1.0),
        "mem": nrm(ks[1], (BATCH, MEM_LEN, D_MODEL), 1.0),
        "g_mix": gain(ks[2], (L, D_MODEL)),
        "w_in": nrm(ks[3], (L, D_MODEL, D_IN), D_MODEL ** -0.5),
        "cmp_pos_k": nrm(ks[4], (L, CMP_BLOCK, NSA_DK), 0.02),
        "cmp_w1_k": nrm(ks[5], (L, CMP_BLOCK * NSA_DK, NSA_DK), (CMP_BLOCK * NSA_DK) ** -0.5),
        "cmp_w2_k": nrm(ks[6], (L, NSA_DK, NSA_DK), NSA_DK ** -0.5),
        "cmp_pos_v": nrm(ks[7], (L, CMP_BLOCK, NSA_DV), 0.02),
        "cmp_w1_v": nrm(ks[8], (L, CMP_BLOCK * NSA_DV, NSA_DV), (CMP_BLOCK * NSA_DV) ** -0.5),
        "cmp_w2_v": nrm(ks[9], (L, NSA_DV, NSA_DV), NSA_DV ** -0.5),
        "mla_g_q": gain(ks[10], (L, MLA_Q_RANK)),
        "mla_w_uq": nrm(ks[11], (L, MLA_Q_RANK, MLA_HEADS * (MLA_NOPE + MLA_ROPE)), MLA_Q_RANK ** -0.5),
        "mla_g_kv": gain(ks[12], (L, MLA_KV_RANK)),
        "mla_w_uk": nrm(ks[13], (L, MLA_KV_RANK, MLA_HEADS * MLA_NOPE), MLA_KV_RANK ** -0.5),
        "mla_w_uv": nrm(ks[14], (L, MLA_KV_RANK, MLA_HEADS * MLA_DV), MLA_KV_RANK ** -0.5),
        "w_o_nsa": nrm(ks[15], (L, NSA_HEADS * NSA_DV, D_MODEL), (NSA_HEADS * NSA_DV) ** -0.5),
        "w_o_mla": nrm(ks[16], (L, MLA_HEADS * MLA_DV, D_MODEL), (MLA_HEADS * MLA_DV) ** -0.5),
        "w_out": nrm(ks[17], (L, D_MODEL, D_MODEL), D_MODEL ** -0.5),
        "g_xattn": gain(ks[18], (L, D_MODEL)),
        "g_mem": gain(ks[19], (L, D_MODEL)),
        "xa_wq": nrm(ks[20], (L, D_MODEL, XA_HEADS * XA_DIM), D_MODEL ** -0.5),
        "xa_wkv": nrm(ks[21], (L, D_MODEL, 2 * XA_HEADS * XA_DIM), D_MODEL ** -0.5),
        "xa_wo": nrm(ks[22], (L, XA_HEADS * XA_DIM, D_MODEL), (XA_HEADS * XA_DIM) ** -0.5),
        "g_mlp": gain(ks[23], (L, D_MODEL)),
        "w_ff1": nrm(ks[24], (L, D_MODEL, D_FF), D_MODEL ** -0.5),
        "w_ff2": nrm(ks[25], (L, D_FF, D_MODEL), D_FF ** -0.5),
        "g_final": gain(ks[26], (D_MODEL,)),
    }


def reference(x, mem, g_mix, w_in, cmp_pos_k, cmp_w1_k, cmp_w2_k, cmp_pos_v, cmp_w1_v, cmp_w2_v,
              mla_g_q, mla_w_uq, mla_g_kv, mla_w_uk, mla_w_uv, w_o_nsa, w_o_mla, w_out,
              g_xattn, g_mem, xa_wq, xa_wkv, xa_wo, g_mlp, w_ff1, w_ff2, g_final):
    b, s, _ = x.shape
    cos_a, sin_a = rope_tables(s, NSA_ROT)
    cos_b, sin_b = rope_tables(s, MLA_ROPE)
    bounds = [int(v) for v in np.cumsum(SPLITS)[:-1]]
    G = NSA_KV_HEADS
    h = x
    for l in range(DEPTH):
        xn = rmsnorm(h, g_mix[l])
        (q_a, k_c, v_c, k_s, v_s, k_w, v_w, g_nsa, c_q, c_kv, k_r,
         gate_a, gate_b) = jnp.split(xn @ w_in[l], bounds, axis=-1)
        q_a = partial_rope(q_a.reshape(b, s, NSA_HEADS, NSA_DK), cos_a, sin_a)
        k_c = partial_rope(k_c.reshape(b, s, G, NSA_DK), cos_a, sin_a)
        k_s = partial_rope(k_s.reshape(b, s, G, NSA_DK), cos_a, sin_a)
        k_w = partial_rope(k_w.reshape(b, s, G, NSA_DK), cos_a, sin_a)
        v_c = v_c.reshape(b, s, G, NSA_DV)
        v_s = v_s.reshape(b, s, G, NSA_DV)
        v_w = v_w.reshape(b, s, G, NSA_DV)
        g_nsa = jax.nn.sigmoid(g_nsa.reshape(b, s, NSA_HEADS, 3))
        o_a = nsa_attention(q_a, k_c, v_c, k_s, v_s, k_w, v_w, g_nsa,
                            cmp_pos_k[l], cmp_w1_k[l], cmp_w2_k[l],
                            cmp_pos_v[l], cmp_w1_v[l], cmp_w2_v[l])
        o_b = mla_attention(c_q, c_kv, k_r, mla_g_q[l], mla_w_uq[l], mla_g_kv[l],
                            mla_w_uk[l], mla_w_uv[l], cos_b, sin_b)
        mixed = (jax.nn.sigmoid(gate_a) * (o_a @ w_o_nsa[l])
                 + jax.nn.sigmoid(gate_b) * (o_b @ w_o_mla[l]))
        h = h + mixed @ w_out[l]
        h = h + memory_cross_attention(rmsnorm(h, g_xattn[l]), rmsnorm(mem, g_mem[l]),
                                       xa_wq[l], xa_wkv[l], xa_wo[l])
        hn = rmsnorm(h, g_mlp[l])
        h = h + jnp.square(jax.nn.relu(hn @ w_ff1[l])) @ w_ff2[l]
    return rmsnorm(h, g_final)
```

```cpp
#include <hip/hip_runtime.h>
#include <hip/hip_cooperative_groups.h>
#include <cstdio>
namespace cg = cooperative_groups;

#define LAS __attribute__((address_space(3)))
#define DI __device__ __forceinline__
typedef unsigned short bf16_t;
typedef short bf16x8 __attribute__((ext_vector_type(8)));
typedef short s16x4 __attribute__((ext_vector_type(4)));
typedef float f32x4 __attribute__((ext_vector_type(4)));
typedef float f32x16 __attribute__((ext_vector_type(16)));
typedef unsigned u32x4 __attribute__((ext_vector_type(4)));
typedef unsigned u32x2 __attribute__((ext_vector_type(2)));

constexpr int SEQ = 8192, BATCH = 4, T = BATCH * SEQ, DM = 2048, DFF = 8192, MEM = 256;
constexpr int DIN = 8400;
constexpr float EPS = 1e-6f;
constexpr int NTHREADS = 512;
constexpr int LDS_BYTES = 131072;

constexpr size_t al256(size_t x) { return (x + 255) & ~(size_t)255; }
constexpr size_t O_WIN = 0;
constexpr size_t O_WG = O_WIN + (size_t)4352 * 2048 * 2;
constexpr size_t O_WUQ = O_WG + (size_t)4096 * 2048 * 2;
constexpr size_t O_WUK = O_WUQ + (size_t)1536 * 512 * 2;
constexpr size_t O_WUV = O_WUK + (size_t)1024 * 256 * 2;
constexpr size_t O_W1K = O_WUV + (size_t)1024 * 256 * 2;
constexpr size_t O_W1V = O_W1K + (size_t)96 * 3072 * 2;
constexpr size_t O_W2K = O_W1V + (size_t)64 * 2048 * 2;
constexpr size_t O_W2V = al256(O_W2K + 96 * 96 * 2);
constexpr size_t O_WONA = al256(O_W2V + 64 * 64 * 2);
constexpr size_t O_WONB = O_WONA + (size_t)2048 * 1024 * 2;
constexpr size_t O_WOUT = O_WONB + (size_t)2048 * 1024 * 2;
constexpr size_t O_WXQ = O_WOUT + (size_t)2048 * 2048 * 2;
constexpr size_t O_WXKV = O_WXQ + (size_t)512 * 2048 * 2;
constexpr size_t O_WXO = O_WXKV + (size_t)1024 * 2048 * 2;
constexpr size_t O_WFF1 = O_WXO + (size_t)2048 * 512 * 2;
constexpr size_t O_WFF2 = O_WFF1 + (size_t)8192 * 2048 * 2;
constexpr size_t O_BIASK = O_WFF2 + (size_t)2048 * 8192 * 2;
constexpr size_t O_COSA = al256(O_BIASK + 1024);
constexpr size_t O_SINA = O_COSA + (size_t)SEQ * 12 * 4;
constexpr size_t O_COSB = O_SINA + (size_t)SEQ * 12 * 4;
constexpr size_t O_SINB = O_COSB + (size_t)SEQ * 16 * 4;
constexpr size_t O_SSQ = O_SINB + (size_t)SEQ * 16 * 4;
constexpr size_t O_MEMN = O_SSQ + (size_t)5 * T * 4;
constexpr size_t O_KMEM = O_MEMN + (size_t)1024 * 2048 * 2;
constexpr size_t O_VMEM = O_KMEM + (size_t)1024 * 512 * 2;
constexpr size_t O_KCC = O_VMEM + (size_t)1024 * 512 * 2;
constexpr size_t O_VCC = O_KCC + (size_t)4 * 512 * 4 * 96 * 2;
constexpr size_t O_HK = O_VCC + (size_t)4 * 512 * 4 * 64 * 2;
constexpr size_t O_HV = O_HK + (size_t)8192 * 96 * 2;
constexpr size_t O_SEL = O_HV + (size_t)8192 * 64 * 2;
constexpr size_t O_GN = O_SEL + (size_t)T * 4 * 16;
constexpr size_t O_XN = al256(O_GN + (size_t)T * 48 * 4);
constexpr size_t O_OACC = O_XN + (size_t)T * 2048 * 2;
constexpr size_t O_OB = O_OACC + (size_t)T * 1024 * 4;
constexpr size_t O_R = O_OB + (size_t)T * 1024 * 2;
constexpr size_t O_QA = O_R;
constexpr size_t O_KS = O_QA + (size_t)T * 1536 * 2;
constexpr size_t O_VS = O_KS + (size_t)T * 384 * 2;
constexpr size_t O_KC = O_VS + (size_t)T * 256 * 2;
constexpr size_t O_KW = O_KC + (size_t)T * 384 * 2;
constexpr size_t O_VC = O_KW + (size_t)T * 384 * 2;
constexpr size_t O_VW = O_VC + (size_t)T * 256 * 2;
constexpr size_t O_CQ = O_VW + (size_t)T * 256 * 2;
constexpr size_t O_CKV = O_CQ + (size_t)T * 512 * 2;
constexpr size_t O_QMLA = O_CKV + (size_t)T * 256 * 2;
constexpr size_t O_KMLA = O_QMLA + (size_t)T * 1536 * 2;
constexpr size_t O_VMLA = O_KMLA + (size_t)T * 1536 * 2;
constexpr size_t O_END = O_VMLA + (size_t)T * 1024 * 2;
constexpr size_t O_OA = O_KC;
constexpr size_t O_GATES = O_QMLA;
constexpr size_t O_MIXED = O_QA;
constexpr size_t O_QX = O_KC;
constexpr size_t O_OX = O_KC + (size_t)T * 512 * 2;
constexpr size_t O_U = O_R;
static_assert(O_GATES + (size_t)T * 4096 * 2 <= O_END, "gates alias");
static_assert(O_U + (size_t)T * 8192 * 2 <= O_END, "u alias");
constexpr size_t O_BAR = O_END;
constexpr int XCD_BAR_WORDS = 3456;
constexpr size_t O_END2 = O_BAR + (size_t)XCD_BAR_WORDS * 4;
static_assert(O_END2 <= (size_t)1073741824, "workspace");

struct Params {
    const float *x, *mem, *g_mix, *w_in, *cmp_pos_k, *cmp_w1_k, *cmp_w2_k, *cmp_pos_v, *cmp_w1_v, *cmp_w2_v,
        *mla_g_q, *mla_w_uq, *mla_g_kv, *mla_w_uk, *mla_w_uv, *w_o_nsa, *w_o_mla, *w_out, *g_xattn, *g_mem,
        *xa_wq, *xa_wkv, *xa_wo, *g_mlp, *w_ff1, *w_ff2, *g_final;
    float* out;
    unsigned char* ws;
    int ph_lo, ph_hi;
};

DI float bf2f(unsigned b) { return __uint_as_float(b << 16); }
typedef float f32x2_t __attribute__((ext_vector_type(2)));
typedef __bf16 bf16x2_t __attribute__((ext_vector_type(2)));
DI unsigned pk2(float lo, float hi) { const f32x2_t v = {lo, hi}; return __builtin_bit_cast(unsigned, __builtin_convertvector(v, bf16x2_t)); }
DI bf16_t f2bf(float f) { return (bf16_t)(pk2(f, 0.f) & 0xffffu); }
DI float ex2(float x) { return __builtin_amdgcn_exp2f(x); }
DI float sigm(float x) { return __builtin_amdgcn_rcpf(1.f + __builtin_amdgcn_exp2f(-1.4426950408889634f * x)); }
DI float xhalf_max(float x) { const auto r = __builtin_amdgcn_permlane32_swap(__float_as_uint(x), __float_as_uint(x), false, false); return fmaxf(__uint_as_float(r[0]), __uint_as_float(r[1])); }
DI float xhalf_sum(float x) { const auto r = __builtin_amdgcn_permlane32_swap(__float_as_uint(x), __float_as_uint(x), false, false); return __uint_as_float(r[0]) + __uint_as_float(r[1]); }
DI float wave_sum(float v) {
#pragma unroll
    for (int o = 32; o > 0; o >>= 1) v += __shfl_xor(v, o);
    return v;
}
DI int permNSA(int p) { return p < 24 ? ((p & 1) ? 12 + (p >> 1) : (p >> 1)) : p; }
DI int permMLA(int p) { return (p & 1) ? 16 + (p >> 1) : (p >> 1); }
DI u32x4 pack8(f32x4 a, f32x4 b) { u32x4 w; w.x = pk2(a[0], a[1]); w.y = pk2(a[2], a[3]); w.z = pk2(b[0], b[1]); w.w = pk2(b[2], b[3]); return w; }
DI void unpack8(u32x4 w, f32x4& a, f32x4& b) {
    a[0] = bf2f(w.x & 0xffffu); a[1] = bf2f(w.x >> 16); a[2] = bf2f(w.y & 0xffffu); a[3] = bf2f(w.y >> 16);
    b[0] = bf2f(w.z & 0xffffu); b[1] = bf2f(w.z >> 16); b[2] = bf2f(w.w & 0xffffu); b[3] = bf2f(w.w >> 16);
}
DI void rope8(f32x4& a, f32x4& b, f32x4 c, f32x4 s) {
    float o0 = a[0] * c[0] - a[1] * s[0], o1 = a[0] * s[0] + a[1] * c[0];
    float o2 = a[2] * c[1] - a[3] * s[1], o3 = a[2] * s[1] + a[3] * c[1];
    float o4 = b[0] * c[2] - b[1] * s[2], o5 = b[0] * s[2] + b[1] * c[2];
    float o6 = b[2] * c[3] - b[3] * s[3], o7 = b[2] * s[3] + b[3] * c[3];
    a[0] = o0; a[1] = o1; a[2] = o2; a[3] = o3; b[0] = o4; b[1] = o5; b[2] = o6; b[3] = o7;
}
DI float sumsq8(f32x4 a, f32x4 b) { return a[0]*a[0] + a[1]*a[1] + a[2]*a[2] + a[3]*a[3] + b[0]*b[0] + b[1]*b[1] + b[2]*b[2] + b[3]*b[3]; }

namespace pg8 {
constexpr int BM = 256, BK = 64, HALF = 128, HTB = HALF * BK * 2, STAGE_BYTES = 8 * HTB, NXCD = 8, WGM = 8;
DI int lds_byte(int r, int c) { const int st = (r >> 4) * 2 + (c >> 5), rr = r & 15, cc = c & 31, ob = rr * 64 + cc * 2; return st * 1024 + (ob ^ (((ob >> 9) & 1) << 5)); }
DI void stage_rc(int b, int& R, int& C) { const int st = b / 1024, sb = b % 1024, swz = sb ^ (((sb >> 9) & 1) << 5); R = (st >> 1) * 16 + swz / 64; C = (st & 1) * 32 + (swz % 64) / 2; }
DI int perm32(int rho) { const int n = rho >> 4, i = rho & 15; return 8 * (i >> 2) + 4 * n + (i & 3); }
struct Unit { int pm, pn; };
struct Gemm { const bf16_t* A; const bf16_t* Bt; int M, N, K; };
struct StaticOrder {
    int nM, nN, nwg, G, c;
    DI void init(int M, int N, int G_, int c_) { nM = M / BM; nN = N / BM; nwg = nM * nN; G = G_; c = c_; }
    DI bool next(int i, Unit& u) const {
        const long L = (long)i * G + c; if (L >= nwg) return false;
        int wgid = (int)L; { const int q = nwg / NXCD, r = nwg % NXCD, xcd = wgid % NXCD, off = wgid / NXCD; wgid = (xcd < r ? xcd * (q + 1) : r * (q + 1) + (xcd - r) * q) + off; }
        const int nig = WGM * nN, gid = wgid / nig, fm = gid * WGM, gsz = (nM - fm) < WGM ? (nM - fm) : WGM;
        u.pm = fm + ((wgid % nig) % gsz); u.pn = (wgid % nig) / gsz; return true;
    }
};

template <class Epi>
DI void gemm_phase(LAS unsigned char* lds, const Gemm g, const StaticOrder& S, const Epi& E) {
    const int tid = threadIdx.x, wid = __builtin_amdgcn_readfirstlane(tid >> 6), lane = tid & 63, wr = wid >> 2, wc = wid & 3, fr = lane & 15, fq = lane >> 4;
    const int K = g.K, nt = K / BK;
    unsigned voffA[2], voffB[2];
#pragma unroll
    for (int i = 0; i < 2; ++i) { int R, C; stage_rc(tid * 16 + i * 8192, R, C); const int Rb = (R & ~31) + perm32(R & 31);
        voffA[i] = (unsigned)(R * K + C) * 2u; voffB[i] = (unsigned)(Rb * K + C) * 2u; }
    const size_t kstep = (size_t)(BK * 2);
    const size_t hstep = (size_t)HALF * K * 2;
    const size_t tstep = 2 * hstep;
    const unsigned ldsw = (unsigned)wid * 1024u;
    const int aoff = lds_byte(wr * 64 + fr, fq * 8), boff = lds_byte(wc * 32 + fr, fq * 8);
#define PG8_SA(b, h) (((b) * 2 + (h)) * HTB)
#define PG8_SB(b, h) ((4 + (b) * 2 + (h)) * HTB)
#define PG8_STAGE(bufoff, gbase, voff) do { _Pragma("unroll") for (int _i = 0; _i < 2; ++_i) \
        __builtin_amdgcn_global_load_lds((const unsigned*)((const char*)(gbase) + (voff)[_i]), (LAS unsigned*)(lds + (bufoff) + ldsw + _i * 8192), 16, 0, 0); } while (0)
#define PG8_LDA(dst, b, h) do { _Pragma("unroll") for (int m = 0; m < 4; ++m) _Pragma("unroll") for (int k = 0; k < 2; ++k) dst[m][k] = *(const LAS bf16x8*)(lds + PG8_SA(b, h) + aoff + m * 2048 + k * 1024); } while (0)
#define PG8_LDB(dst, b, h) do { _Pragma("unroll") for (int n = 0; n < 2; ++n) _Pragma("unroll") for (int k = 0; k < 2; ++k) dst[n][k] = *(const LAS bf16x8*)(lds + PG8_SB(b, h) + boff + n * 2048 + k * 1024); } while (0)
#define PG8_MMA(ai, bj, At, Bt) do { __builtin_amdgcn_s_setprio(1); _Pragma("unroll") for (int m = 0; m < 4; ++m) _Pragma("unroll") for (int n = 0; n < 2; ++n) _Pragma("unroll") for (int k = 0; k < 2; ++k) \
        acc[ai][bj][m][n] = __builtin_amdgcn_mfma_f32_16x16x32_bf16(Bt[n][k], At[m][k], acc[ai][bj][m][n], 0, 0, 0); __builtin_amdgcn_s_setprio(0); } while (0)
#define PG8_WAIT_V(n) asm volatile("s_waitcnt vmcnt(" #n ")" ::: "memory")
#define PG8_WAIT_L(n) asm volatile("s_waitcnt lgkmcnt(" #n ")" ::: "memory")
#define PG8_BAR __builtin_amdgcn_s_barrier()
#define PG8_SCHED __builtin_amdgcn_sched_barrier(0)
    Unit cur, nxt; int ui = 0;
    if (!S.next(0, cur)) return;
    f32x4 acc[2][2][4][2];
#pragma unroll
    for (int a = 0; a < 2; ++a)
#pragma unroll
        for (int b = 0; b < 2; ++b)
#pragma unroll
            for (int m = 0; m < 4; ++m)
#pragma unroll
                for (int n = 0; n < 2; ++n) acc[a][b][m][n] = (f32x4){0.f, 0.f, 0.f, 0.f};
    bf16x8 At[4][2], B0[2][2], B1[2][2];
    const char* cA = (const char*)g.A + (size_t)cur.pm * tstep; const char* cB = (const char*)g.Bt + (size_t)cur.pn * tstep;
    PG8_STAGE(PG8_SB(0, 0), cB, voffB); PG8_STAGE(PG8_SA(0, 0), cA, voffA); PG8_STAGE(PG8_SB(0, 1), cB + hstep, voffB); PG8_STAGE(PG8_SA(0, 1), cA + hstep, voffA);
    if (wr == 1) PG8_BAR;
    PG8_WAIT_V(4); PG8_BAR;
    PG8_STAGE(PG8_SB(1, 0), cB + kstep, voffB); PG8_STAGE(PG8_SA(1, 0), cA + kstep, voffA); PG8_STAGE(PG8_SB(1, 1), cB + hstep + kstep, voffB);
    PG8_WAIT_V(6); PG8_BAR;
    for (;;) {
        const bool has_next = S.next(ui + 1, nxt);
        const char* nA = has_next ? (const char*)g.A + (size_t)nxt.pm * tstep : cA; const char* nB = has_next ? (const char*)g.Bt + (size_t)nxt.pn * tstep : cB;
#pragma unroll 1
        for (int t = 0; t < nt; t += 2) {
            const bool last = (t == nt - 2);
            const char* a1 = cA + (size_t)(t + 1) * kstep;
            const char* a2 = last ? nA : cA + (size_t)(t + 2) * kstep; const char* b2 = last ? nB : cB + (size_t)(t + 2) * kstep;
            const char* a3 = a2 + kstep; const char* b3 = b2 + kstep;
            PG8_LDB(B0, 0, 0); PG8_SCHED; PG8_LDA(At, 0, 0); PG8_STAGE(PG8_SA(1, 1), a1 + hstep, voffA);
            PG8_WAIT_L(8); PG8_BAR; PG8_WAIT_L(0); PG8_MMA(0, 0, At, B0); PG8_BAR; PG8_SCHED;
            PG8_LDB(B1, 0, 1); PG8_STAGE(PG8_SB(0, 0), b2, voffB);
            PG8_BAR; PG8_WAIT_L(0); PG8_MMA(0, 1, At, B1); PG8_BAR;
            PG8_LDA(At, 0, 1); PG8_STAGE(PG8_SA(0, 0), a2, voffA);
            PG8_BAR; PG8_WAIT_L(0); PG8_MMA(1, 0, At, B0); PG8_BAR; PG8_SCHED;
            PG8_STAGE(PG8_SB(0, 1), b2 + hstep, voffB);
            PG8_WAIT_V(6); PG8_BAR; PG8_MMA(1, 1, At, B1); PG8_BAR;
            PG8_LDB(B0, 1, 0); PG8_SCHED; PG8_LDA(At, 1, 0); PG8_STAGE(PG8_SA(0, 1), a2 + hstep, voffA);
            PG8_WAIT_L(8); PG8_BAR; PG8_WAIT_L(0); PG8_MMA(0, 0, At, B0); PG8_BAR; PG8_SCHED;
            PG8_LDB(B1, 1, 1); PG8_STAGE(PG8_SB(1, 0), b3, voffB);
            PG8_BAR; PG8_WAIT_L(0); PG8_MMA(0, 1, At, B1); PG8_BAR;
            PG8_LDA(At, 1, 1); PG8_STAGE(PG8_SA(1, 0), a3, voffA);
            PG8_BAR; PG8_WAIT_L(0); PG8_MMA(1, 0, At, B0); PG8_BAR; PG8_SCHED;
            PG8_STAGE(PG8_SB(1, 1), b3 + hstep, voffB);
            PG8_WAIT_V(6); PG8_BAR; PG8_MMA(1, 1, At, B1); PG8_BAR;
        }
        E(acc, cur, wr, wc, fr, fq);
        if (!has_next) break;
#pragma unroll
        for (int a = 0; a < 2; ++a)
#pragma unroll
            for (int b = 0; b < 2; ++b)
#pragma unroll
                for (int m = 0; m < 4; ++m)
#pragma unroll
                    for (int n = 0; n < 2; ++n) acc[a][b][m][n] = (f32x4){0.f, 0.f, 0.f, 0.f};
        cur = nxt; cA = nA; cB = nB; ++ui;
    }
    PG8_WAIT_V(0);
    if (wr == 0) PG8_BAR;
    PG8_BAR;
#undef PG8_SA
#undef PG8_SB
#undef PG8_STAGE
#undef PG8_LDA
#undef PG8_LDB
#undef PG8_MMA
#undef PG8_WAIT_V
#undef PG8_WAIT_L
#undef PG8_BAR
#undef PG8_SCHED
}
}

struct NoPre {};
template <class F> struct EpiT {
    F f;
    DI void operator()(const f32x4 (&acc)[2][2][4][2], const pg8::Unit& u, int wr, int wc, int fr, int fq) const {
#pragma unroll
        for (int ai = 0; ai < 2; ++ai) {
            typename F::Pre pre[4][2];
#pragma unroll
            for (int m = 0; m < 4; ++m)
#pragma unroll
                for (int bj = 0; bj < 2; ++bj) pre[m][bj] = f.load(u.pm * 256 + ai * 128 + wr * 64 + m * 16 + fr, u.pn * 256 + bj * 128 + wc * 32 + 8 * fq);
#pragma unroll
            for (int m = 0; m < 4; ++m)
#pragma unroll
                for (int bj = 0; bj < 2; ++bj) f.apply(u.pm * 256 + ai * 128 + wr * 64 + m * 16 + fr, u.pn * 256 + bj * 128 + wc * 32 + 8 * fq, acc[ai][bj][m][0], acc[ai][bj][m][1], pre[m][bj]);
        }
    }
};
template <class F> DI void run_gemm(LAS unsigned char* lds, const bf16_t* A, const bf16_t* Bt, int M, int N, int K, const F& f, int rot) {
    pg8::Gemm g{A, Bt, M, N, K}; pg8::StaticOrder S; S.init(M, N, (int)gridDim.x, (int)((blockIdx.x + rot) % gridDim.x));
    EpiT<F> E{f};
    pg8::gemm_phase(lds, g, S, E);
}

struct FGemm1 {
    unsigned char* ws; int col0;
    typedef NoPre Pre; DI Pre load(int, int) const { return Pre{}; }
    DI void apply(int row, int gc0, f32x4 a, f32x4 b, const Pre&) const {
        const int gc = gc0 + col0;
        const int pos = row & (SEQ - 1);
        if (gc < 2688) {
            const int m = gc < 1536 ? gc : gc - 1536;
            const int p = m % 96;
            if (p < 24) rope8(a, b, *(const f32x4*)((const float*)(ws + O_COSA) + pos * 12 + (p >> 1)), *(const f32x4*)((const float*)(ws + O_SINA) + pos * 12 + (p >> 1)));
            size_t off;
            if (gc < 1536) off = O_QA + ((size_t)row * 1536 + gc) * 2;
            else { const int seg = m / 384, c = m % 384; off = (seg == 0 ? O_KC : (seg == 1 ? O_KS : O_KW)) + ((size_t)row * 384 + c) * 2; }
            *(u32x4*)(ws + off) = pack8(a, b);
        } else if (gc < 3456) {
            const int m = gc - 2688, seg = m >> 8, c = m & 255;
            const size_t off = (seg == 0 ? O_VC : (seg == 1 ? O_VS : O_VW)) + ((size_t)row * 256 + c) * 2;
            *(u32x4*)(ws + off) = pack8(a, b);
        } else if (gc < 3712) {
            *(u32x4*)(ws + O_CKV + ((size_t)row * 256 + (gc - 3456)) * 2) = pack8(a, b);
            float s = sumsq8(a, b); s += __shfl_xor(s, 16); s += __shfl_xor(s, 32);
            if ((threadIdx.x & 63) < 16) atomicAdd((float*)(ws + O_SSQ) + T + row, s);
        } else if (gc < 3744) {
            const int p = gc - 3712;
            rope8(a, b, *(const f32x4*)((const float*)(ws + O_COSB) + pos * 16 + (p >> 1)), *(const f32x4*)((const float*)(ws + O_SINB) + pos * 16 + (p >> 1)));
            const u32x4 w = pack8(a, b);
            bf16_t* d = (bf16_t*)(ws + O_KMLA) + (size_t)row * 1536 + 64 + p;
            for (int h = 0; h < 16; ++h) *(u32x4*)(d + h * 96) = w;
        } else if (gc < 3792) {
            float* d = (float*)(ws + O_GN) + (size_t)row * 48 + (gc - 3744);
            *(f32x4*)d = (f32x4){sigm(a[0]), sigm(a[1]), sigm(a[2]), sigm(a[3])};
            *(f32x4*)(d + 4) = (f32x4){sigm(b[0]), sigm(b[1]), sigm(b[2]), sigm(b[3])};
        } else if (gc >= 3840) {
            *(u32x4*)(ws + O_CQ + ((size_t)row * 512 + (gc - 3840)) * 2) = pack8(a, b);
            float s = sumsq8(a, b); s += __shfl_xor(s, 16); s += __shfl_xor(s, 32);
            if ((threadIdx.x & 63) < 16) atomicAdd((float*)(ws + O_SSQ) + row, s);
        }
    }
};
struct FMemKV { bf16_t *Km, *Vm;
    typedef NoPre Pre; DI Pre load(int, int) const { return Pre{}; }
    DI void apply(int row, int gc, f32x4 a, f32x4 b, const Pre&) const {
        bf16_t* d = gc < 512 ? Km + (size_t)row * 512 + gc : Vm + (size_t)row * 512 + (gc - 512);
        *(u32x4*)d = pack8(a, b); } };
struct FUq { unsigned char* ws;
    typedef float Pre; DI Pre load(int row, int) const { return ((const float*)(ws + O_SSQ))[row]; }
    DI void apply(int row, int gc, f32x4 a, f32x4 b, const Pre& pre) const {
        const float rs = rsqrtf(pre * (1.f / 512.f) + EPS); a *= rs; b *= rs;
        const int p = gc % 96, pos = row & (SEQ - 1);
        if (p >= 64) rope8(a, b, *(const f32x4*)((const float*)(ws + O_COSB) + pos * 16 + ((p - 64) >> 1)), *(const f32x4*)((const float*)(ws + O_SINB) + pos * 16 + ((p - 64) >> 1)));
        *(u32x4*)(ws + O_QMLA + ((size_t)row * 1536 + gc) * 2) = pack8(a, b); } };
struct FUkv { unsigned char* ws;
    typedef float Pre; DI Pre load(int row, int) const { return ((const float*)(ws + O_SSQ))[T + row]; }
    DI void apply(int row, int gc, f32x4 a, f32x4 b, const Pre& pre) const {
        const float rs = rsqrtf(pre * (1.f / 256.f) + EPS); a *= rs; b *= rs;
        const size_t off = gc < 1024 ? O_KMLA + ((size_t)row * 1536 + (gc >> 6) * 96 + (gc & 63)) * 2 : O_VMLA + ((size_t)row * 1024 + (gc - 1024)) * 2;
        *(u32x4*)(ws + off) = pack8(a, b); } };
struct FGate { bf16_t* g;
    typedef NoPre Pre; DI Pre load(int, int) const { return Pre{}; }
    DI void apply(int row, int gc, f32x4 a, f32x4 b, const Pre&) const {
#pragma unroll
        for (int i = 0; i < 4; ++i) { a[i] = sigm(a[i]); b[i] = sigm(b[i]); }
        *(u32x4*)(g + (size_t)row * 4096 + gc) = pack8(a, b); } };
template <int SECOND> struct FMix { const bf16_t* g; bf16_t* mixed;
    struct Pre { u32x4 g, mx; };
    DI Pre load(int row, int gc) const { Pre p; p.g = *(const u32x4*)(g + (size_t)row * 4096 + SECOND * 2048 + gc); if (SECOND) p.mx = *(const u32x4*)(mixed + (size_t)row * 2048 + gc); return p; }
    DI void apply(int row, int gc, f32x4 a, f32x4 b, const Pre& pre) const {
        f32x4 ga, gb; unpack8(pre.g, ga, gb);
        a *= ga; b *= gb;
        if (SECOND) { f32x4 pa, pb; unpack8(pre.mx, pa, pb); a += pa; b += pb; }
        *(u32x4*)(mixed + (size_t)row * 2048 + gc) = pack8(a, b); } };
template <int MODE> struct FResid { const float* base; float* out; bf16_t* hb; float* ssq;
    struct Pre { f32x4 a, b; u32x4 h; };
    DI Pre load(int row, int gc) const { Pre p;
        if (MODE == 0) { const float* bp = base + (size_t)row * 2048 + gc; p.a = *(const f32x4*)bp; p.b = *(const f32x4*)(bp + 4); }
        else p.h = *(const u32x4*)(hb + (size_t)row * 2048 + gc);
        return p; }
    DI void apply(int row, int gc, f32x4 a, f32x4 b, const Pre& pre) const {
        if (MODE == 0) { a += pre.a; b += pre.b; }
        else { f32x4 pa, pb; unpack8(pre.h, pa, pb); a += pa; b += pb; }
        if (MODE == 2) { float* op = out + (size_t)row * 2048 + gc; *(f32x4*)op = a; *(f32x4*)(op + 4) = b; }
        else *(u32x4*)(hb + (size_t)row * 2048 + gc) = pack8(a, b);
        float s = sumsq8(a, b); s += __shfl_xor(s, 16); s += __shfl_xor(s, 32);
        if ((threadIdx.x & 63) < 16) atomicAdd(ssq + row, s); } };
struct FXq { bf16_t* q; const float* ssq;
    typedef float Pre; DI Pre load(int row, int) const { return ssq[row]; }
    DI void apply(int row, int gc, f32x4 a, f32x4 b, const Pre& pre) const {
        const float rs = rsqrtf(pre * (1.f / 2048.f) + EPS); a *= rs; b *= rs;
        *(u32x4*)(q + (size_t)row * 512 + gc) = pack8(a, b); } };
struct FFf1 { bf16_t* u; const float* ssq;
    typedef float Pre; DI Pre load(int row, int) const { return ssq[row]; }
    DI void apply(int row, int gc, f32x4 a, f32x4 b, const Pre& pre) const {
        const float rs = rsqrtf(pre * (1.f / 2048.f) + EPS);
#pragma unroll
        for (int i = 0; i < 4; ++i) { float z = fmaxf(a[i] * rs, 0.f); a[i] = z * z; z = fmaxf(b[i] * rs, 0.f); b[i] = z * z; }
        *(u32x4*)(u + (size_t)row * 8192 + gc) = pack8(a, b); } };

template <int NMAP> DI int nmap(int n) {
    if (NMAP == 0) return n;
    if (NMAP == 1) {
        if (n < 1536) { const int h = n / 96, p = n % 96; return h * 96 + permNSA(p); }
        if (n < 2688) { const int m = n - 1536, seg = m / 384, c = m % 384, hh = c / 96, p = c % 96; const int sb = seg == 0 ? 1536 : (seg == 1 ? 2176 : 2816); return sb + hh * 96 + permNSA(p); }
        if (n < 3456) { const int m = n - 2688, seg = m >> 8, c = m & 255; const int sb = seg == 0 ? 1920 : (seg == 1 ? 2560 : 3200); return sb + c; }
        if (n < 3712) return 4016 + (n - 3456);
        if (n < 3744) return 4272 + permMLA(n - 3712);
        if (n < 3792) return 3456 + (n - 3744);
        if (n < 3840) return -1;
        return 3504 + (n - 3840);
    }
    if (NMAP == 2) { const int h = n / 96, p = n % 96; return p < 64 ? n : h * 96 + 64 + permMLA(p - 64); }
    return n;
}
template <int KMAP> DI int kmap(int k) { if (KMAP == 1) { const int l = k / 96, p = k % 96; return l * 96 + permNSA(p); } return k; }

template <int NMAP, int KMAP>
DI void transpose_w(const float* __restrict__ src, int ldsrc, int K, bf16_t* __restrict__ dst, int Ndst, const float* __restrict__ kscale, LAS float* tile) {
    const int tn = (Ndst + 63) / 64, tk = K / 64, ntiles = tn * tk;
    if (NMAP == 0 && KMAP == 0) {
        for (int t = blockIdx.x; t < ntiles; t += gridDim.x) {
            const int in = t % tn, ik = t / tn;
#pragma unroll
            for (int i = 0; i < 2; ++i) { const int e = threadIdx.x + i * NTHREADS, kk = e >> 4, n4 = (e & 15) * 4, k = ik * 64 + kk, n = in * 64 + n4;
                f32x4 v = (f32x4){0.f, 0.f, 0.f, 0.f};
                if (n < Ndst) v = *(const f32x4*)(src + (size_t)k * ldsrc + n);
                if (kscale) v *= kscale[k];
                tile[kk * 65 + n4] = v[0]; tile[kk * 65 + n4 + 1] = v[1]; tile[kk * 65 + n4 + 2] = v[2]; tile[kk * 65 + n4 + 3] = v[3]; }
            __syncthreads();
            { const int nn = threadIdx.x >> 3, k8 = (threadIdx.x & 7) * 8, n = in * 64 + nn;
              u32x4 w; w.x = pk2(tile[(k8 + 0) * 65 + nn], tile[(k8 + 1) * 65 + nn]); w.y = pk2(tile[(k8 + 2) * 65 + nn], tile[(k8 + 3) * 65 + nn]);
              w.z = pk2(tile[(k8 + 4) * 65 + nn], tile[(k8 + 5) * 65 + nn]); w.w = pk2(tile[(k8 + 6) * 65 + nn], tile[(k8 + 7) * 65 + nn]);
              if (n < Ndst) *(u32x4*)(dst + (size_t)n * K + ik * 64 + k8) = w; }
            __syncthreads();
        }
        return;
    }
    for (int t = blockIdx.x; t < ntiles; t += gridDim.x) {
        const int in = t % tn, ik = t / tn;
        for (int e = threadIdx.x; e < 4096; e += NTHREADS) {
            const int kk = e >> 6, nn = e & 63, n = in * 64 + nn, k = ik * 64 + kk;
            const int sc = (n < Ndst) ? nmap<NMAP>(n) : -1;
            const int sr = kmap<KMAP>(k);
            float v = (sc >= 0) ? src[(size_t)sr * ldsrc + sc] : 0.f;
            if (kscale) v *= kscale[sr];
            tile[kk * 65 + nn] = v;
        }
        __syncthreads();
        for (int e = threadIdx.x; e < 2048; e += NTHREADS) {
            const int nn = e >> 5, k2 = (e & 31) * 2, n = in * 64 + nn;
            if (n < Ndst) *(unsigned*)(dst + (size_t)n * K + ik * 64 + k2) = pk2(tile[k2 * 65 + nn], tile[(k2 + 1) * 65 + nn]);
        }
        __syncthreads();
    }
}

DI void rmsnorm_rows(const float* __restrict__ src, const float* __restrict__ g, bf16_t* __restrict__ dst, int nrows) {
    const int lane = threadIdx.x & 63, gw = blockIdx.x * (NTHREADS / 64) + (threadIdx.x >> 6), nw = gridDim.x * (NTHREADS / 64);
    for (int row = gw; row < nrows; row += nw) {
        f32x4 v[8]; float ss = 0.f;
#pragma unroll
        for (int i = 0; i < 8; ++i) { v[i] = *(const f32x4*)(src + (size_t)row * 2048 + (i * 64 + lane) * 4); ss += v[i][0] * v[i][0] + v[i][1] * v[i][1] + v[i][2] * v[i][2] + v[i][3] * v[i][3]; }
        ss = wave_sum(ss);
        const float rs = rsqrtf(ss * (1.f / 2048.f) + EPS);
#pragma unroll
        for (int i = 0; i < 8; ++i) { const f32x4 gv = *(const f32x4*)(g + (i * 64 + lane) * 4);
            u32x2 w; w.x = pk2(v[i][0] * rs * gv[0], v[i][1] * rs * gv[1]); w.y = pk2(v[i][2] * rs * gv[2], v[i][3] * rs * gv[3]);
            *(u32x2*)(dst + (size_t)row * 2048 + (i * 64 + lane) * 4) = w; }
    }
}

DI void phase_prep(const Params& p, LAS unsigned char* lds) {
    unsigned char* ws = p.ws;
    LAS float* tile = (LAS float*)lds;
    const int gtid = blockIdx.x * NTHREADS + threadIdx.x, gsz = gridDim.x * NTHREADS;
    { float* z = (float*)(ws + O_SSQ); for (int i = gtid; i < 5 * T; i += gsz) z[i] = 0.f; }
    { float *cA = (float*)(ws + O_COSA), *sA = (float*)(ws + O_SINA), *cB = (float*)(ws + O_COSB), *sB = (float*)(ws + O_SINB);
      for (int i = gtid; i < SEQ * 12; i += gsz) { const int pos = i / 12, j = i % 12; const float inv = 1.0f / powf(500000.0f, (float)(2 * j) / 24.0f); const float ang = (float)pos * inv; cA[i] = cosf(ang); sA[i] = sinf(ang); }
      for (int i = gtid; i < SEQ * 16; i += gsz) { const int pos = i / 16, j = i % 16; const float inv = 1.0f / powf(500000.0f, (float)(2 * j) / 32.0f); const float ang = (float)pos * inv; cB[i] = cosf(ang); sB[i] = sinf(ang); } }
    if (blockIdx.x == 1 % gridDim.x) {
        const int n = threadIdx.x & 127, part = threadIdx.x >> 7;
        float s = 0.f;
        if (n < 96) for (int k = part * 768; k < (part + 1) * 768; ++k) s += p.cmp_pos_k[k] * p.cmp_w1_k[(size_t)k * 96 + n];
        tile[threadIdx.x] = s; __syncthreads();
        if (threadIdx.x < 96) ((float*)(ws + O_BIASK))[threadIdx.x] = tile[threadIdx.x] + tile[threadIdx.x + 128] + tile[threadIdx.x + 256] + tile[threadIdx.x + 384];
        __syncthreads();
        s = 0.f;
        if (n < 64) for (int k = part * 512; k < (part + 1) * 512; ++k) s += p.cmp_pos_v[k] * p.cmp_w1_v[(size_t)k * 64 + n];
        tile[threadIdx.x] = s; __syncthreads();
        if (threadIdx.x < 64) ((float*)(ws + O_BIASK))[96 + threadIdx.x] = tile[threadIdx.x] + tile[threadIdx.x + 128] + tile[threadIdx.x + 256] + tile[threadIdx.x + 384];
        __syncthreads();
    }
    if (blockIdx.x == 2 % gridDim.x) {
        bf16_t* w2k = (bf16_t*)(ws + O_W2K); bf16_t* w2v = (bf16_t*)(ws + O_W2V);
        for (int e = threadIdx.x; e < 96 * 96; e += NTHREADS) { const int n = e / 96, k = e % 96; w2k[e] = f2bf(p.cmp_w2_k[k * 96 + permNSA(n)]); }
        for (int e = threadIdx.x; e < 64 * 64; e += NTHREADS) { const int n = e >> 6, k = e & 63; w2v[e] = f2bf(p.cmp_w2_v[k * 64 + n]); }
    }
    rmsnorm_rows(p.x, p.g_mix, (bf16_t*)(ws + O_XN), T);
    rmsnorm_rows(p.mem, p.g_mem, (bf16_t*)(ws + O_MEMN), BATCH * MEM);
    transpose_w<1, 0>(p.w_in, DIN, 2048, (bf16_t*)(ws + O_WIN), 4352, nullptr, tile);
    transpose_w<0, 0>(p.w_in + 4304, DIN, 2048, (bf16_t*)(ws + O_WG), 4096, nullptr, tile);
    transpose_w<2, 0>(p.mla_w_uq, 1536, 512, (bf16_t*)(ws + O_WUQ), 1536, p.mla_g_q, tile);
    transpose_w<0, 0>(p.mla_w_uk, 1024, 256, (bf16_t*)(ws + O_WUK), 1024, p.mla_g_kv, tile);
    transpose_w<0, 0>(p.mla_w_uv, 1024, 256, (bf16_t*)(ws + O_WUV), 1024, p.mla_g_kv, tile);
    transpose_w<0, 1>(p.cmp_w1_k, 96, 3072, (bf16_t*)(ws + O_W1K), 96, nullptr, tile);
    transpose_w<0, 0>(p.cmp_w1_v, 64, 2048, (bf16_t*)(ws + O_W1V), 64, nullptr, tile);
    transpose_w<0, 0>(p.w_o_nsa, 2048, 1024, (bf16_t*)(ws + O_WONA), 2048, nullptr, tile);
    transpose_w<0, 0>(p.w_o_mla, 2048, 1024, (bf16_t*)(ws + O_WONB), 2048, nullptr, tile);
    transpose_w<0, 0>(p.w_out, 2048, 2048, (bf16_t*)(ws + O_WOUT), 2048, nullptr, tile);
    transpose_w<0, 0>(p.xa_wq, 512, 2048, (bf16_t*)(ws + O_WXQ), 512, p.g_xattn, tile);
    transpose_w<0, 0>(p.xa_wkv, 1024, 2048, (bf16_t*)(ws + O_WXKV), 1024, nullptr, tile);
    transpose_w<0, 0>(p.xa_wo, 2048, 512, (bf16_t*)(ws + O_WXO), 2048, nullptr, tile);
    transpose_w<0, 0>(p.w_ff1, 8192, 2048, (bf16_t*)(ws + O_WFF1), 8192, p.g_mlp, tile);
    transpose_w<0, 0>(p.w_ff2, 2048, 8192, (bf16_t*)(ws + O_WFF2), 2048, nullptr, tile);
}

DI float gelu_tanh(float x) { const float u = 0.7978845608028654f * (x + 0.044715f * x * x * x); return 0.5f * x * (1.f + tanhf(u)); }

template <int DH> DI void compress_stage1(const bf16_t* __restrict__ X  , const bf16_t* __restrict__ W1t  , const float* __restrict__ bias, bf16_t* __restrict__ H, int task) {
    constexpr int NB = DH / 16, SPL = DH / 32;
    const int lane = threadIdx.x & 63, fr = lane & 15, fq = lane >> 4;
    const int bg = task >> 5, ct = task & 31, b = bg >> 2, g = bg & 3;
    int c = ct * 16 + fr; if (c > 510) c = 510;
    const bf16_t* arow = X + ((size_t)(b * SEQ + 16 * c) * 4 + g) * DH + 8 * fq;
    const bf16_t* brow = W1t + (size_t)fr * (32 * DH) + 8 * fq;
    f32x4 acc[NB];
#pragma unroll
    for (int n = 0; n < NB; ++n) acc[n] = (f32x4){0.f, 0.f, 0.f, 0.f};
    for (int l = 0; l < 32; ++l) {
#pragma unroll
        for (int s2 = 0; s2 < SPL; ++s2) {
            const bf16x8 a = *(const bf16x8*)(arow + (size_t)l * 4 * DH + s2 * 32);
            const int koff = l * DH + s2 * 32;
#pragma unroll
            for (int n = 0; n < NB; ++n) { const bf16x8 bb = *(const bf16x8*)(brow + (size_t)n * 16 * (32 * DH) + koff);
                acc[n] = __builtin_amdgcn_mfma_f32_16x16x32_bf16(a, bb, acc[n], 0, 0, 0); }
        }
    }
#pragma unroll
    for (int n = 0; n < NB; ++n)
#pragma unroll
        for (int j = 0; j < 4; ++j) { const int cc = ct * 16 + fq * 4 + j, col = n * 16 + fr;
            H[((size_t)(b * 512 + cc) * 4 + g) * DH + col] = f2bf(gelu_tanh(acc[n][j] + bias[col])); }
}
template <int DH> DI void compress_stage2(const bf16_t* __restrict__ H, const bf16_t* __restrict__ W2t  , bf16_t* __restrict__ O, int task) {
    constexpr int NB = DH / 16, KS = DH / 32;
    const int lane = threadIdx.x & 63, fr = lane & 15, fq = lane >> 4;
    const int bg = task >> 5, ct = task & 31, b = bg >> 2, g = bg & 3;
    int c = ct * 16 + fr; if (c > 510) c = 510;
    const bf16_t* arow = H + ((size_t)(b * 512 + c) * 4 + g) * DH + 8 * fq;
    f32x4 acc[NB];
#pragma unroll
    for (int n = 0; n < NB; ++n) acc[n] = (f32x4){0.f, 0.f, 0.f, 0.f};
#pragma unroll
    for (int s = 0; s < KS; ++s) { const bf16x8 a = *(const bf16x8*)(arow + s * 32);
#pragma unroll
        for (int n = 0; n < NB; ++n) { const bf16x8 bb = *(const bf16x8*)(W2t + (size_t)(n * 16 + fr) * DH + s * 32 + 8 * fq);
            acc[n] = __builtin_amdgcn_mfma_f32_16x16x32_bf16(a, bb, acc[n], 0, 0, 0); } }
#pragma unroll
    for (int n = 0; n < NB; ++n)
#pragma unroll
        for (int j = 0; j < 4; ++j) { const int cc = ct * 16 + fq * 4 + j, col = n * 16 + fr;
            O[((size_t)(b * 512 + cc) * 4 + g) * DH + col] = (cc > 510) ? (bf16_t)0 : f2bf(acc[n][j]); }
}

template <int DK, int DV> struct ALay {
    static constexpr int KSB = DK * 2 + 16, VSB = DV * 2 + 64;
    static constexpr int KBYTES = 64 * KSB, VBYTES = 64 * VSB, BUF = KBYTES + VBYTES;
    static constexpr int NPK = 64 * DK / 8, NPV = 64 * DV / 8;
    static constexpr int KI = (NPK + NTHREADS - 1) / NTHREADS, VI = (NPV + NTHREADS - 1) / NTHREADS;
};
constexpr int IMPS = 129;
constexpr int LDS_IMP = 77824, LDS_UNI = 77824 + 64 * 129 * 4 + 256;

template <int DK, int DV>
DI void tile_load(const bf16_t* __restrict__ Kt, int kstride, const bf16_t* __restrict__ Vt, int vstride, u32x4 (&kr)[ALay<DK, DV>::KI], u32x4 (&vr)[ALay<DK, DV>::VI]) {
    using L = ALay<DK, DV>;
#pragma unroll
    for (int i = 0; i < L::KI; ++i) { const int pi = threadIdx.x + i * NTHREADS; if (pi < L::NPK) { const int row = pi / (DK / 8), ch = pi % (DK / 8); kr[i] = *(const u32x4*)(Kt + (size_t)row * kstride + ch * 8); } }
#pragma unroll
    for (int i = 0; i < L::VI; ++i) { const int pi = threadIdx.x + i * NTHREADS; if (pi < L::NPV) { const int row = pi / (DV / 8), ch = pi % (DV / 8); vr[i] = *(const u32x4*)(Vt + (size_t)row * vstride + ch * 8); } }
}
template <int DK, int DV>
DI void tile_store(LAS unsigned char* kb, const u32x4 (&kr)[ALay<DK, DV>::KI], const u32x4 (&vr)[ALay<DK, DV>::VI]) {
    using L = ALay<DK, DV>;
#pragma unroll
    for (int i = 0; i < L::KI; ++i) { const int pi = threadIdx.x + i * NTHREADS; if (pi < L::NPK) { const int row = pi / (DK / 8), ch = pi % (DK / 8); *(LAS u32x4*)(kb + row * L::KSB + ch * 16) = kr[i]; } }
#pragma unroll
    for (int i = 0; i < L::VI; ++i) { const int pi = threadIdx.x + i * NTHREADS; if (pi < L::NPV) { const int row = pi / (DV / 8), ch = pi % (DV / 8); *(LAS u32x4*)(kb + L::KBYTES + row * L::VSB + ch * 16) = vr[i]; } }
}

struct AttnIn {
    const bf16_t* q;
    const bf16_t *K, *V;
    int kstride, vstride;
    int jlo, jhi;
    int t;
    int tw_lo, tw_hi;
    float sc;
    unsigned long long sel_lo, sel_hi;
    unsigned long long wsel_lo, wsel_hi;
    int tt;
};

template <int MODE> DI bool key_ok(int key, int t) {
    if (MODE == 0 || MODE == 3) return key <= t;
    if (MODE == 1) return key <= t && key >= t - 511;
    if (MODE == 2) return 16 * key + 31 <= t;
    return true;
}

template <int DK, int DV>
DI void tile_pv(LAS unsigned char* kb, const f32x16& S0, const f32x16& S1, f32x16 (&O)[DV / 32]) {
    using L = ALay<DK, DV>;
    const int lane = threadIdx.x & 63, h = lane >> 5, i16 = lane & 15, q4 = i16 >> 2, p4 = i16 & 3, g16 = lane >> 4;
    LAS unsigned char* vb_ = kb + L::KBYTES;
    __builtin_amdgcn_s_setprio(1);
#pragma unroll
    for (int kb2 = 0; kb2 < 2; ++kb2)
#pragma unroll
        for (int s2 = 0; s2 < 2; ++s2) {
            u32x4 pw;
            if (kb2 == 0) { pw.x = pk2(S0[8 * s2 + 0], S0[8 * s2 + 1]); pw.y = pk2(S0[8 * s2 + 2], S0[8 * s2 + 3]); pw.z = pk2(S0[8 * s2 + 4], S0[8 * s2 + 5]); pw.w = pk2(S0[8 * s2 + 6], S0[8 * s2 + 7]); }
            else          { pw.x = pk2(S1[8 * s2 + 0], S1[8 * s2 + 1]); pw.y = pk2(S1[8 * s2 + 2], S1[8 * s2 + 3]); pw.z = pk2(S1[8 * s2 + 4], S1[8 * s2 + 5]); pw.w = pk2(S1[8 * s2 + 6], S1[8 * s2 + 7]); }
            const bf16x8 pb = __builtin_bit_cast(bf16x8, pw);
            const int vrow = 32 * kb2 + 16 * s2 + 4 * h + q4;
#pragma unroll
            for (int d = 0; d < DV / 32; ++d) {
                const int vcol = d * 32 + 16 * (g16 & 1) + 4 * p4;
                const s16x4 lo = __builtin_amdgcn_ds_read_tr16_b64_v4i16((LAS s16x4*)(vb_ + vrow * L::VSB + vcol * 2));
                const s16x4 hi = __builtin_amdgcn_ds_read_tr16_b64_v4i16((LAS s16x4*)(vb_ + (vrow + 8) * L::VSB + vcol * 2));
                bf16x8 va; va[0] = lo[0]; va[1] = lo[1]; va[2] = lo[2]; va[3] = lo[3]; va[4] = hi[0]; va[5] = hi[1]; va[6] = hi[2]; va[7] = hi[3];
                O[d] = __builtin_amdgcn_mfma_f32_32x32x16_bf16(va, pb, O[d], 0, 0, 0);
            }
        }
    __builtin_amdgcn_s_setprio(0);
}

template <int DK, int DV>
DI void tile_qk(LAS unsigned char* kb, const bf16x8 (&qf)[DK / 16], f32x16& S0, f32x16& S1) {
    using L = ALay<DK, DV>;
    const int lane = threadIdx.x & 63, r = lane & 31, h = lane >> 5;
    const f32x16 z16 = {0.f, 0.f, 0.f, 0.f, 0.f, 0.f, 0.f, 0.f, 0.f, 0.f, 0.f, 0.f, 0.f, 0.f, 0.f, 0.f};
    __builtin_amdgcn_s_setprio(1);
#pragma unroll
    for (int s = 0; s < DK / 16; ++s) {
        const bf16x8 a0 = *(const LAS bf16x8*)(kb + r * L::KSB + (16 * s + 8 * h) * 2);
        const bf16x8 a1 = *(const LAS bf16x8*)(kb + (32 + r) * L::KSB + (16 * s + 8 * h) * 2);
        S0 = __builtin_amdgcn_mfma_f32_32x32x16_bf16(a0, qf[s], s == 0 ? z16 : S0, 0, 0, 0);
        S1 = __builtin_amdgcn_mfma_f32_32x32x16_bf16(a1, qf[s], s == 0 ? z16 : S1, 0, 0, 0);
    }
    __builtin_amdgcn_s_setprio(0);
}
template <int DK, int DV, int MODE, int PASS, bool FULL>
DI void tile_smpv(LAS unsigned char* lds, LAS unsigned char* kb, const AttnIn& in, int j, f32x16& S0, f32x16& S1, f32x16 (&O)[DV / 32], float& m, float& l, float inv_l) {
    const int lane = threadIdx.x & 63, h = lane >> 5;
    const int key0 = j * 64;
    const unsigned long long selw = (j < 64) ? in.sel_lo : in.sel_hi;
    const bool rowsel = (MODE == 3) ? ((selw >> (j & 63)) & 1ull) : true;
    if (FULL && PASS == 0) {
        float mx = fmaxf(S0[0], S1[0]);
#pragma unroll
        for (int i = 1; i < 16; ++i) mx = fmaxf(mx, fmaxf(S0[i], S1[i]));
        const float rb = (MODE == 3 && !rowsel) ? -1e30f : 0.f;
        mx = mx * in.sc + rb;
        mx = xhalf_max(mx);
        const float mn = fmaxf(m, mx);
        const float alpha = ex2(m - mn);
        m = mn;
        const float off = rb - mn;
        float ls = 0.f;
#pragma unroll
        for (int i = 0; i < 16; ++i) { const float p0 = ex2(__builtin_fmaf(S0[i], in.sc, off)), p1 = ex2(__builtin_fmaf(S1[i], in.sc, off)); S0[i] = p0; S1[i] = p1; ls += p0 + p1; }
        l = l * alpha + ls;
        if (__any(alpha != 1.f)) {
#pragma unroll
            for (int d = 0; d < DV / 32; ++d) O[d] *= alpha;
        }
        tile_pv<DK, DV>(kb, S0, S1, O);
        return;
    }
    int thr = 63, lo = 0;
    if (MODE == 0 || MODE == 3) thr = in.t - key0 - 4 * h;
    if (MODE == 1) { thr = in.t - key0 - 4 * h; lo = thr - 511; }
    if (MODE == 2) thr = ((in.t - 31) >> 4) - key0 - 4 * h;
    if (MODE == 3 && !rowsel) thr = -1;
#define VOK(c) (FULL || (MODE == 4) || (((c) <= thr) && (MODE != 1 || (c) >= lo)))
    if (PASS != 2) {
        float mx = -1e30f;
#pragma unroll
        for (int i = 0; i < 16; ++i) { const int c = 8 * (i >> 2) + (i & 3); S0[i] *= in.sc; S1[i] *= in.sc;
            mx = fmaxf(mx, VOK(c) ? S0[i] : -1e30f); mx = fmaxf(mx, VOK(c + 32) ? S1[i] : -1e30f); }
        mx = xhalf_max(mx);
        const float mn = fmaxf(m, mx);
        const float alpha = ex2(m - mn);
        m = mn;
        float ls = 0.f;
#pragma unroll
        for (int i = 0; i < 16; ++i) { const int c = 8 * (i >> 2) + (i & 3);
            const float p0 = VOK(c) ? ex2(S0[i] - mn) : 0.f; const float p1 = VOK(c + 32) ? ex2(S1[i] - mn) : 0.f;
            S0[i] = p0; S1[i] = p1; ls += p0 + p1; }
        l = l * alpha + ls;
        if (PASS == 0) {
#pragma unroll
            for (int d = 0; d < DV / 32; ++d) O[d] *= alpha;
        }
    } else {
#pragma unroll
        for (int i = 0; i < 16; ++i) { const int c = 8 * (i >> 2) + (i & 3);
            const float p0 = VOK(c) ? ex2(S0[i] * in.sc - m) * inv_l : 0.f; const float p1 = VOK(c + 32) ? ex2(S1[i] * in.sc - m) * inv_l : 0.f;
            S0[i] = p0; S1[i] = p1; }
#undef VOK
        LAS unsigned* imp = (LAS unsigned*)(lds + LDS_IMP) + in.tt * IMPS;
#pragma unroll
        for (int kb2 = 0; kb2 < 2; ++kb2)
#pragma unroll
            for (int g4 = 0; g4 < 4; ++g4) {
                const float e0 = kb2 ? S1[4 * g4] : S0[4 * g4], e1 = kb2 ? S1[4 * g4 + 1] : S0[4 * g4 + 1], e2 = kb2 ? S1[4 * g4 + 2] : S0[4 * g4 + 2], e3 = kb2 ? S1[4 * g4 + 3] : S0[4 * g4 + 3];
                const int js = (key0 >> 2) + 8 * kb2 + 2 * g4 + h;
                const unsigned wm = (unsigned)((e0 + e1 + e2 + 0.5f * e3) * 536870912.f + 0.5f);
                const unsigned wh = (unsigned)(0.5f * e3 * 536870912.f + 0.5f);
                if (wm != 0u) __hip_atomic_fetch_add(imp + js, wm, __ATOMIC_RELAXED, __HIP_MEMORY_SCOPE_WORKGROUP);
                if (wh != 0u && js + 1 < 128) __hip_atomic_fetch_add(imp + js + 1, wh, __ATOMIC_RELAXED, __HIP_MEMORY_SCOPE_WORKGROUP);
            }
    }
    if (PASS != 1) tile_pv<DK, DV>(kb, S0, S1, O);
}

DI void lds_barrier() { asm volatile("s_waitcnt lgkmcnt(0)" ::: "memory"); __builtin_amdgcn_s_barrier(); asm volatile("" ::: "memory"); }
template <int MODE> DI void tile_flags(const AttnIn& in, int j, bool& wave_on, bool& full) {
    const int key0 = j * 64;
    wave_on = true; full = false;
    if (MODE == 0 || MODE == 3) { wave_on = key0 <= in.tw_hi; full = key0 + 63 <= in.tw_lo; }
    if (MODE == 3) wave_on = wave_on && ((((j < 64) ? in.wsel_lo : in.wsel_hi) >> (j & 63)) & 1ull);
    if (MODE == 1) { wave_on = (key0 <= in.tw_hi) && (key0 + 63 >= in.tw_lo - 511); full = (key0 + 63 <= in.tw_lo) && (key0 >= in.tw_hi - 511); }
    if (MODE == 2) { wave_on = 16 * key0 + 31 <= in.tw_hi; full = 16 * (key0 + 63) + 31 <= in.tw_lo; }
    if (MODE == 4) full = true;
}
template <int DK, int DV, int MODE, int PASS>
DI void smpv_dispatch(LAS unsigned char* lds, LAS unsigned char* kb, const AttnIn& in, int j, f32x16& S0, f32x16& S1, f32x16 (&O)[DV / 32], float& m, float& l, float inv_l) {
    bool wave_on, full; tile_flags<MODE>(in, j, wave_on, full);
    if (!wave_on) return;
    if (PASS == 0 && full) tile_smpv<DK, DV, MODE, PASS, true>(lds, kb, in, j, S0, S1, O, m, l, inv_l);
    else tile_smpv<DK, DV, MODE, PASS, false>(lds, kb, in, j, S0, S1, O, m, l, inv_l);
}
template <int DK, int DV, int MODE, int PASS>
DI void attn_stream(LAS unsigned char* lds, const AttnIn& in, const bf16x8 (&qf)[DK / 16], f32x16 (&O)[DV / 32], float& m, float& l) {
    using L = ALay<DK, DV>;
    static_assert(2 * L::BUF <= LDS_IMP, "tile buffers");
    u32x4 kr[L::KI], vr[L::VI];
    int j = in.jlo;
    LAS const unsigned* uni = (LAS const unsigned*)(lds + LDS_UNI);
    auto tile_on = [&](int jj) -> bool { if (MODE == 3) return (uni[jj >> 5] >> (jj & 31)) & 1u; return true; };
    while (j <= in.jhi && !tile_on(j)) ++j;
    if (j > in.jhi) return;
    const float inv_l = (PASS == 2) ? 1.f / fmaxf(l, 1e-30f) : 0.f;
    tile_load<DK, DV>(in.K + (size_t)j * 64 * in.kstride, in.kstride, in.V + (size_t)j * 64 * in.vstride, in.vstride, kr, vr);
    tile_store<DK, DV>(lds, kr, vr);
    __syncthreads();
    int cur = 0;
    f32x16 S0, S1;
    for (;;) {
        int jn = j + 1;
        while (jn <= in.jhi && !tile_on(jn)) ++jn;
        const bool has_next = jn <= in.jhi;
        if (has_next) tile_load<DK, DV>(in.K + (size_t)jn * 64 * in.kstride, in.kstride, in.V + (size_t)jn * 64 * in.vstride, in.vstride, kr, vr);
        LAS unsigned char* kb = lds + cur * L::BUF;
        bool wave_on, full; tile_flags<MODE>(in, j, wave_on, full);
        if (wave_on) {
            tile_qk<DK, DV>(kb, qf, S0, S1);
            if ((PASS == 0 || MODE == 2) && full) tile_smpv<DK, DV, MODE, PASS, true>(lds, kb, in, j, S0, S1, O, m, l, inv_l);
            else tile_smpv<DK, DV, MODE, PASS, false>(lds, kb, in, j, S0, S1, O, m, l, inv_l);
        }
        if (has_next) tile_store<DK, DV>(lds + (cur ^ 1) * L::BUF, kr, vr);
        lds_barrier();
        if (!has_next) break;
        j = jn; cur ^= 1;
    }
}

template <int DK> DI void load_q(const bf16_t* q, bf16x8 (&qf)[DK / 16]) {
    const int h = (threadIdx.x & 63) >> 5;
#pragma unroll
    for (int s = 0; s < DK / 16; ++s) qf[s] = *(const bf16x8*)(q + 16 * s + 8 * h);
}
template <int NV> DI void zeroO(f32x16 (&O)[NV]) {
#pragma unroll
    for (int d = 0; d < NV; ++d)
#pragma unroll
        for (int i = 0; i < 16; ++i) O[d][i] = 0.f;
}

template <int DK, int DV, int MODE>
DI void attn_mha_item(LAS unsigned char* lds, const bf16_t* Q, int qstride, const bf16_t* K, int kstride, const bf16_t* V, int vstride, bf16_t* Out, int ostride, int t0, int jhi, float sc) {
    const int wid = threadIdx.x >> 6, lane = threadIdx.x & 63, r = lane & 31, h = lane >> 5;
    AttnIn in; in.t = t0 + 32 * wid + r; in.tw_lo = t0 + 32 * wid; in.tw_hi = in.tw_lo + 31;
    in.q = Q + (size_t)in.t * qstride; in.K = K; in.V = V; in.kstride = kstride; in.vstride = vstride; in.jlo = 0; in.jhi = jhi; in.sc = sc;
    in.sel_lo = in.sel_hi = 0ull; in.wsel_lo = in.wsel_hi = ~0ull; in.tt = 0;
    bf16x8 qf[DK / 16]; load_q<DK>(in.q, qf);
    f32x16 O[DV / 32]; zeroO(O);
    float m = -1e30f, l = 0.f;
    attn_stream<DK, DV, MODE, 0>(lds, in, qf, O, m, l);
    l = xhalf_sum(l);
    const float inv = 1.f / fmaxf(l, 1e-30f);
    bf16_t* o = Out + (size_t)in.t * ostride;
#pragma unroll
    for (int d = 0; d < DV / 32; ++d)
#pragma unroll
        for (int g4 = 0; g4 < 4; ++g4) { u32x2 w; w.x = pk2(O[d][4 * g4] * inv, O[d][4 * g4 + 1] * inv); w.y = pk2(O[d][4 * g4 + 2] * inv, O[d][4 * g4 + 3] * inv);
            *(u32x2*)(o + d * 32 + 8 * g4 + 4 * h) = w; }
}

template <int BR>
DI void nsa_item(LAS unsigned char* lds, const Params& p, int b, int g, int qt) {
    unsigned char* ws = p.ws;
    const int wid = threadIdx.x >> 6, lane = threadIdx.x & 63, r = lane & 31, h = lane >> 5;
    const int head = (BR == 3) ? 4 * g + (r >> 3) : 4 * g + (wid >> 1), t0 = qt * 64;
    AttnIn in;
    if (BR == 3) { in.tt = 8 * wid + (r & 7); in.tw_lo = t0 + 8 * wid; in.tw_hi = in.tw_lo + 7; }
    else { in.tt = 32 * (wid & 1) + r; in.tw_lo = t0 + 32 * (wid & 1); in.tw_hi = in.tw_lo + 31; }
    in.t = t0 + in.tt; in.wsel_lo = in.wsel_hi = ~0ull;
    const size_t tok = (size_t)b * SEQ + in.t;
    in.q = (const bf16_t*)(ws + O_QA) + (tok * 16 + head) * 96;
    in.sc = 0.10206207261596577f * 1.4426950408889634f;
    in.sel_lo = in.sel_hi = 0ull;
    const float* gnp = (const float*)(ws + O_GN) + tok * 48 + head * 3;
    bf16_t* oacc = (bf16_t*)(ws + O_OACC) + tok * 1024 + head * 64;
    bf16x8 qf[6]; load_q<96>(in.q, qf);
    f32x16 O[2]; zeroO(O);
    float m = -1e30f, l = 0.f;
    if (BR == 1) {
        in.K = (const bf16_t*)(ws + O_KW) + ((size_t)b * SEQ * 4 + g) * 96; in.kstride = 384;
        in.V = (const bf16_t*)(ws + O_VW) + ((size_t)b * SEQ * 4 + g) * 64; in.vstride = 256;
        in.jlo = qt >= 8 ? qt - 8 : 0; in.jhi = qt;
        attn_stream<96, 64, 1, 0>(lds, in, qf, O, m, l);
        l = xhalf_sum(l);
        const float sc = gnp[2] / fmaxf(l, 1e-30f);
#pragma unroll
        for (int d = 0; d < 2; ++d)
#pragma unroll
            for (int g4 = 0; g4 < 4; ++g4) { u32x2 w; w.x = pk2(O[d][4 * g4] * sc, O[d][4 * g4 + 1] * sc); w.y = pk2(O[d][4 * g4 + 2] * sc, O[d][4 * g4 + 3] * sc); *(u32x2*)(oacc + d * 32 + 8 * g4 + 4 * h) = w; }
    }
    if (BR == 2) {
#ifdef DBG_KW
        in.K = (const bf16_t*)(ws + O_KCC) + ((size_t)b * 512 * 4 + g) * 96; in.kstride = 384;
        in.V = (const bf16_t*)(ws + O_VW) + ((size_t)b * SEQ * 4 + g) * 64; in.vstride = 256;
#else
        in.K = (const bf16_t*)(ws + O_KCC) + ((size_t)b * 512 * 4 + g) * 96; in.kstride = 384;
        in.V = (const bf16_t*)(ws + O_VCC) + ((size_t)b * 512 * 4 + g) * 64; in.vstride = 256;
#endif
        in.jlo = 0; in.jhi = ((t0 + 32) >> 4) >> 6;
        LAS unsigned* imp = (LAS unsigned*)(lds + LDS_IMP);
        for (int i = threadIdx.x; i < 64 * IMPS; i += NTHREADS) imp[i] = 0u;
        attn_stream<96, 64, 2, 1>(lds, in, qf, O, m, l);
        l = xhalf_sum(l);
        zeroO(O);
        attn_stream<96, 64, 2, 2>(lds, in, qf, O, m, l);
        const float sc = gnp[0];
#pragma unroll
        for (int d = 0; d < 2; ++d)
#pragma unroll
            for (int g4 = 0; g4 < 4; ++g4) { u32x2* dp = (u32x2*)(oacc + d * 32 + 8 * g4 + 4 * h); const u32x2 hw = *dp;
                u32x2 w; w.x = pk2(bf2f(hw.x & 0xffffu) + O[d][4 * g4] * sc, bf2f(hw.x >> 16) + O[d][4 * g4 + 1] * sc); w.y = pk2(bf2f(hw.y & 0xffffu) + O[d][4 * g4 + 2] * sc, bf2f(hw.y >> 16) + O[d][4 * g4 + 3] * sc); *dp = w; }
#ifndef DBG_NO_IMP
        const int cur = qt;
        u32x4* selp = (u32x4*)(ws + O_SEL);
#pragma unroll 1
        for (int rr = 0; rr < 8; ++rr) {
            const int tt = wid * 8 + rr;
            LAS const unsigned* row = imp + tt * IMPS;
            unsigned long long blo, bhi;
            if (cur < 16) { blo = __ballot(lane <= cur); bhi = 0ull; }
            else {
                const int ja = lane, jb = lane + 64;
                const bool fa = (ja == 0) || (ja == cur) || (ja == cur - 1), fb = (jb == cur) || (jb == cur - 1);
                const unsigned xa = (ja <= cur) ? (fa ? 0xffffffffu : row[ja] + 1u) : 0u, xb = (jb <= cur) ? (fb ? 0xffffffffu : row[jb] + 1u) : 0u;
                unsigned Tk = 0u;
#pragma unroll 1
                for (int bit = 31; bit >= 0; --bit) { const unsigned c = Tk | (1u << bit);
                    const int cnt = __popcll(__ballot(xa >= c)) + __popcll(__ballot(xb >= c)); if (cnt >= 16) Tk = c; }
                const int ngt = __popcll(__ballot(xa > Tk)) + __popcll(__ballot(xb > Tk));
                const int need = 16 - ngt;
                const unsigned long long ta = __ballot(xa == Tk), tb = __ballot(xb == Tk), lt = (1ull << lane) - 1ull;
                const int pa = __popcll(ta & lt), pb = __popcll(ta) + __popcll(tb & lt);
                blo = __ballot(xa > Tk || (xa == Tk && pa < need)); bhi = __ballot(xb > Tk || (xb == Tk && pb < need));
            }
            if (lane == 0) { u32x4 w; w.x = (unsigned)blo; w.y = (unsigned)(blo >> 32); w.z = (unsigned)bhi; w.w = (unsigned)(bhi >> 32);
                selp[((size_t)b * SEQ + t0 + tt) * 4 + g] = w; }
        }
#endif
        __syncthreads();
    }
    if (BR == 3) {
        in.K = (const bf16_t*)(ws + O_KS) + ((size_t)b * SEQ * 4 + g) * 96; in.kstride = 384;
        in.V = (const bf16_t*)(ws + O_VS) + ((size_t)b * SEQ * 4 + g) * 64; in.vstride = 256;
        in.jlo = 0; in.jhi = qt;
        const u32x4 sw = ((const u32x4*)(ws + O_SEL))[tok * 4 + g];
        in.sel_lo = (unsigned long long)sw.x | ((unsigned long long)sw.y << 32); in.sel_hi = (unsigned long long)sw.z | ((unsigned long long)sw.w << 32);
        LAS unsigned* uni = (LAS unsigned*)(lds + LDS_UNI);
        if (threadIdx.x < 4) uni[threadIdx.x] = 0u;
        __syncthreads();
        { unsigned long long wl = in.sel_lo, wh = in.sel_hi;
#pragma unroll
          for (int o = 1; o < 8; o <<= 1) { wl |= __shfl_xor(wl, o); wh |= __shfl_xor(wh, o); }
          in.wsel_lo = __builtin_amdgcn_readfirstlane((unsigned)wl) | ((unsigned long long)__builtin_amdgcn_readfirstlane((unsigned)(wl >> 32)) << 32);
          in.wsel_hi = __builtin_amdgcn_readfirstlane((unsigned)wh) | ((unsigned long long)__builtin_amdgcn_readfirstlane((unsigned)(wh >> 32)) << 32); }
        if ((r >> 3) == 0) {
            __hip_atomic_fetch_or(uni + 0, sw.x, __ATOMIC_RELAXED, __HIP_MEMORY_SCOPE_WORKGROUP); __hip_atomic_fetch_or(uni + 1, sw.y, __ATOMIC_RELAXED, __HIP_MEMORY_SCOPE_WORKGROUP);
            __hip_atomic_fetch_or(uni + 2, sw.z, __ATOMIC_RELAXED, __HIP_MEMORY_SCOPE_WORKGROUP); __hip_atomic_fetch_or(uni + 3, sw.w, __ATOMIC_RELAXED, __HIP_MEMORY_SCOPE_WORKGROUP);
        }
        __syncthreads();
#ifndef DBG_SEL_SKIP
        attn_stream<96, 64, 3, 0>(lds, in, qf, O, m, l);
#endif
        l = xhalf_sum(l);
        const float sc = gnp[1] / fmaxf(l, 1e-30f);
        bf16_t* oa = (bf16_t*)(ws + O_OA) + tok * 1024 + head * 64;
#pragma unroll
        for (int d = 0; d < 2; ++d)
#pragma unroll
            for (int g4 = 0; g4 < 4; ++g4) { const u32x2 hw = *(const u32x2*)(oacc + d * 32 + 8 * g4 + 4 * h);
                u32x2 w; w.x = pk2(bf2f(hw.x & 0xffffu) + O[d][4 * g4] * sc, bf2f(hw.x >> 16) + O[d][4 * g4 + 1] * sc); w.y = pk2(bf2f(hw.y & 0xffffu) + O[d][4 * g4 + 2] * sc, bf2f(hw.y >> 16) + O[d][4 * g4 + 3] * sc);
                *(u32x2*)(oa + d * 32 + 8 * g4 + 4 * h) = w; }
    }
}

DI int snake_rank(int i) { const int G = gridDim.x, b = blockIdx.x; return i * G + ((i & 1) ? (G - 1 - b) : b); }


#define XB_TMO      128
#define XB_XCNT(j)  (256  + 64 * (j))
#define XB_XSUB(j)  (1280 + 64 * (j))
#define XB_XGEN(j)  (2304 + 64 * (j))
#define XB_TOP      3328
#define XB_TOPGEN   3392
#define XB_SPIN_CAP (1u << 18)
DI unsigned xb_ld(unsigned* p)              { return __hip_atomic_load(p, __ATOMIC_RELAXED, __HIP_MEMORY_SCOPE_AGENT); }
DI unsigned xb_add(unsigned* p, unsigned v) { return __hip_atomic_fetch_add(p, v, __ATOMIC_RELAXED, __HIP_MEMORY_SCOPE_AGENT); }
DI unsigned xb_xcc_id() { return (unsigned)__builtin_amdgcn_s_getreg((3 << 11) | 20) & 0xFu; }
#define XB_SPIN(cond, bar) do { unsigned _sp = 0; while (cond) { __builtin_amdgcn_s_sleep(1); \
    if ((++_sp & 255u) == 0u) { if (xb_ld(&(bar)[XB_TMO])) break; if (_sp > XB_SPIN_CAP) { atomicAdd(&(bar)[XB_TMO], 1u); break; } } } } while (0)
struct XcdBarrier { unsigned* bar; unsigned x; volatile LAS unsigned* st; };
DI XcdBarrier xcd_barrier_post(unsigned* bar, volatile LAS unsigned* st) {
    XcdBarrier b; b.bar = bar; b.x = xb_xcc_id(); b.st = st;
    if (threadIdx.x == 0) (void)xb_add(&bar[XB_XCNT(b.x)], 1u);
    return b;
}
DI void xcd_barrier_complete(unsigned* bar, unsigned x, unsigned& nloc, unsigned& nx) {
    const unsigned G = gridDim.x * gridDim.y * gridDim.z;
    unsigned sum, cnt, mine, sp = 0u;
    for (;;) {
        sum = 0u; cnt = 0u; mine = 0u;
#pragma unroll
        for (unsigned j = 0; j < 16; ++j) { const unsigned c = xb_ld(&bar[XB_XCNT(j)]); sum += c; cnt += (c > 0u) ? 1u : 0u; mine = (j == x) ? c : mine; }
        if (sum == G) break;
        __builtin_amdgcn_s_sleep(1);
        if ((++sp & 255u) == 0u) { if (xb_ld(&bar[XB_TMO])) break; if (sp > XB_SPIN_CAP) { atomicAdd(&bar[XB_TMO], 1u); break; } }
    }
    nloc = mine > 0u ? mine : 1u; nx = cnt > 0u ? cnt : 1u;
}
DI void xcd_barrier(const XcdBarrier& b) {
    asm volatile("s_waitcnt vmcnt(0)" ::: "memory");
    __syncthreads();
    if (threadIdx.x == 0) {
        unsigned* bar = b.bar;
        __builtin_amdgcn_s_waitcnt(0);
        unsigned nloc = b.st[0], nx = b.st[1];
        if (nloc == 0u) { xcd_barrier_complete(bar, b.x, nloc, nx); b.st[0] = nloc; b.st[1] = nx; }
        const unsigned old = xb_add(&bar[XB_XSUB(b.x)], 1u);
        const unsigned gen = old / nloc;
        if (old + 1u == (gen + 1u) * nloc) {
            __builtin_amdgcn_fence(__ATOMIC_RELEASE, "agent");
            asm volatile("s_waitcnt vmcnt(0)" ::: "memory");
            const unsigned og = xb_add(&bar[XB_TOP], 1u);
            const unsigned tg = og / nx;
            if (og + 1u == (tg + 1u) * nx) xb_add(&bar[XB_TOPGEN], 1u);
            else XB_SPIN(xb_ld(&bar[XB_TOPGEN]) == tg, bar);
            __builtin_amdgcn_fence(__ATOMIC_ACQUIRE, "agent");
            xb_add(&bar[XB_XGEN(b.x)], 1u);
            asm volatile("s_waitcnt vmcnt(0)" ::: "memory");
        } else {
            XB_SPIN(xb_ld(&bar[XB_XGEN(b.x)]) == gen, bar);
            __builtin_amdgcn_fence(__ATOMIC_ACQUIRE, "agent");
            asm volatile("s_waitcnt vmcnt(0)" ::: "memory");
        }
    }
    __syncthreads();
}

#ifndef PHMASK
#define PHMASK 0xFFFF
#endif
#define PHON(n) ((PHMASK >> (n)) & 1)
__global__ void __launch_bounds__(NTHREADS, 2) fwd_megakernel(Params p_arg) {
    const Params& p = *(const Params*)__builtin_amdgcn_kernarg_segment_ptr();
    extern __shared__ __attribute__((aligned(16))) unsigned char smem[];
    LAS unsigned char* lds = (LAS unsigned char*)smem;
    cg::grid_group grid = cg::this_grid();
    __shared__ uint4 xb_words;
    if (threadIdx.x == 0) xb_words = make_uint4(0u, 0u, 0u, 0u);
    __syncthreads();
    const XcdBarrier xb = xcd_barrier_post((unsigned*)(p_arg.ws + O_BAR), (volatile LAS unsigned*)&xb_words);
    unsigned char* ws = p.ws;
    const int gwave = blockIdx.x * (NTHREADS / 64) + (threadIdx.x >> 6), nwave = gridDim.x * (NTHREADS / 64);
    float* ssq = (float*)(ws + O_SSQ);
    if (PHON(0) && p.ph_lo <= 0 && 0 < p.ph_hi) { phase_prep(p, lds); }
    if (PHON(1) && p.ph_lo <= 1 && 1 < p.ph_hi) { if (1 > p.ph_lo) grid.sync();
            FGemm1 f{ws, 256};
            run_gemm(lds, (const bf16_t*)(ws + O_XN), (const bf16_t*)(ws + O_WIN) + (size_t)256 * 2048, T, 4096, 2048, f, 0);
            FMemKV fm{(bf16_t*)(ws + O_KMEM), (bf16_t*)(ws + O_VMEM)};
            run_gemm(lds, (const bf16_t*)(ws + O_MEMN), (const bf16_t*)(ws + O_WXKV), BATCH * MEM, 1024, 2048, fm, 128);
    }
    if (PHON(2) && p.ph_lo <= 2 && 2 < p.ph_hi) { if (2 > p.ph_lo) xcd_barrier(xb);
#ifndef P2SEL
#define P2SEL 7
#endif
            { FGemm1 f0{ws, 0}; run_gemm(lds, (const bf16_t*)(ws + O_XN), (const bf16_t*)(ws + O_WIN), T, 256, 2048, f0, 128); }
            if (P2SEL & 1) { FUq fq{ws}; run_gemm(lds, (const bf16_t*)(ws + O_CQ), (const bf16_t*)(ws + O_WUQ), T, 1536, 512, fq, 0); }
            if (P2SEL & 2) { FUkv fk{ws}; run_gemm(lds, (const bf16_t*)(ws + O_CKV), (const bf16_t*)(ws + O_WUK), T, 2048, 256, fk, 0); }
#ifndef NO_CMP1
            for (int wt = gwave; wt < 1024; wt += nwave) {
                if (wt < 512) compress_stage1<96>((const bf16_t*)(ws + O_KC), (const bf16_t*)(ws + O_W1K), (const float*)(ws + O_BIASK), (bf16_t*)(ws + O_HK), wt);
                else compress_stage1<64>((const bf16_t*)(ws + O_VC), (const bf16_t*)(ws + O_W1V), (const float*)(ws + O_BIASK) + 96, (bf16_t*)(ws + O_HV), wt - 512);
            }
#endif
    }
    if (PHON(3) && p.ph_lo <= 3 && 3 < p.ph_hi) { if (3 > p.ph_lo) xcd_barrier(xb);
            for (int wt = gwave; wt < 1024; wt += nwave) {
                if (wt < 512) compress_stage2<96>((const bf16_t*)(ws + O_HK), (const bf16_t*)(ws + O_W2K), (bf16_t*)(ws + O_KCC), wt);
                else compress_stage2<64>((const bf16_t*)(ws + O_HV), (const bf16_t*)(ws + O_W2V), (bf16_t*)(ws + O_VCC), wt - 512);
            }
            for (int i = 0;; ++i) { const int rk = snake_rank(i); if (rk >= 2048) break;
                const int qt = 31 - (rk >> 6), bh = rk & 63, b = bh >> 4, hd = bh & 15;
                attn_mha_item<96, 64, 0>(lds, (const bf16_t*)(ws + O_QMLA) + ((size_t)b * SEQ * 16 + hd) * 96, 1536, (const bf16_t*)(ws + O_KMLA) + ((size_t)b * SEQ * 16 + hd) * 96, 1536,
                                         (const bf16_t*)(ws + O_VMLA) + ((size_t)b * SEQ * 16 + hd) * 64, 1024, (bf16_t*)(ws + O_OB) + (size_t)b * SEQ * 1024 + hd * 64, 1024, qt * 256, qt * 4 + 3,
                                         0.10206207261596577f * 1.4426950408889634f); }
#ifndef DBG_NO_NSA
            for (int it = blockIdx.x; it < 2048; it += gridDim.x) { const int qt = it >> 4, bg = it & 15; nsa_item<1>(lds, p, bg >> 2, bg & 3, qt); }
#endif
    }
#ifdef DBG_PROBE
    { grid.sync();
      if (blockIdx.x == 0) {
          unsigned code = 0;
          const bf16_t* bufs[5] = {(const bf16_t*)(ws + O_KC), (const bf16_t*)(ws + O_W1K), (const bf16_t*)(ws + O_HK), (const bf16_t*)(ws + O_W2K), (const bf16_t*)(ws + O_KCC)};
          const int lens[5] = {4 * 1024 * 1024, 96 * 3072, 8192 * 96, 96 * 96, 8192 * 96};
          const int bits[5] = {1, 2, 8, 16, 32};
          LAS unsigned* red = (LAS unsigned*)lds;
          if (threadIdx.x == 0) red[0] = 0u;
          __syncthreads();
          for (int q = 0; q < 5; ++q) { unsigned bad = 0; for (int i = threadIdx.x; i < lens[q]; i += NTHREADS) { if ((bufs[q][i] & 0x7f80u) == 0x7f80u) bad = 1; }
              if (bad) __hip_atomic_fetch_or(red, (unsigned)bits[q], __ATOMIC_RELAXED, __HIP_MEMORY_SCOPE_WORKGROUP); }
          if (threadIdx.x < 160) { const unsigned u = __float_as_uint(((const float*)(ws + O_BIASK))[threadIdx.x]); if ((u & 0x7f800000u) == 0x7f800000u) __hip_atomic_fetch_or(red, 4u, __ATOMIC_RELAXED, __HIP_MEMORY_SCOPE_WORKGROUP); }
          __syncthreads();
          if (threadIdx.x == 0) ((float*)(ws + O_BIASK))[200] = (float)((10 + red[0]) * 100);
          __syncthreads();
      }
    }
#endif
    if (PHON(4) && p.ph_lo <= 4 && 4 < p.ph_hi) { if (4 > p.ph_lo) xcd_barrier(xb);
            for (int i = 0;; ++i) { const int rk = snake_rank(i); if (rk >= 2048) break; const int qt = 127 - (rk >> 4), bg = rk & 15; nsa_item<2>(lds, p, bg >> 2, bg & 3, qt); }
    }
    if (PHON(5) && p.ph_lo <= 5 && 5 < p.ph_hi) { if (5 > p.ph_lo) xcd_barrier(xb);
#ifndef NO_SEL
            for (int i = 0;; ++i) { const int rk = snake_rank(i); if (rk >= 2048) break; const int qt = 127 - (rk >> 4), bg = rk & 15; nsa_item<3>(lds, p, bg >> 2, bg & 3, qt); }
#endif
#ifndef NO_GATE
            FGate fg{(bf16_t*)(ws + O_GATES)};
            run_gemm(lds, (const bf16_t*)(ws + O_XN), (const bf16_t*)(ws + O_WG), T, 4096, 2048, fg, 0);
#endif
    }
    if (PHON(6) && p.ph_lo <= 6 && 6 < p.ph_hi) { if (6 > p.ph_lo) xcd_barrier(xb);
#ifndef DBG_NO_NSA
            FMix<0> fa{(const bf16_t*)(ws + O_GATES), (bf16_t*)(ws + O_MIXED)};
            run_gemm(lds, (const bf16_t*)(ws + O_OA), (const bf16_t*)(ws + O_WONA), T, 2048, 1024, fa, 0);
#endif
            FMix<1> fb{(const bf16_t*)(ws + O_GATES), (bf16_t*)(ws + O_MIXED)};
            run_gemm(lds, (const bf16_t*)(ws + O_OB), (const bf16_t*)(ws + O_WONB), T, 2048, 1024, fb, 0);
    }
    if (PHON(7) && p.ph_lo <= 7 && 7 < p.ph_hi) { if (7 > p.ph_lo) xcd_barrier(xb);
            FResid<0> f{p.x, p.out, (bf16_t*)(ws + O_XN), ssq + 2 * T};
            run_gemm(lds, (const bf16_t*)(ws + O_MIXED), (const bf16_t*)(ws + O_WOUT), T, 2048, 2048, f, 0);
    }
#if defined(DBG_COPY) && DBG_COPY == 2
    { grid.sync();
      const int lane = threadIdx.x & 63;
      for (int row = gwave; row < T; row += nwave) {
          float ss = 0.f;
#pragma unroll
          for (int i = 0; i < 8; ++i) { const size_t o = (size_t)row * 2048 + (i * 64 + lane) * 4; const f32x4 v = *(const f32x4*)(p.x + o); *(f32x4*)(p.out + o) = v;
              u32x2 w; w.x = pk2(v[0], v[1]); w.y = pk2(v[2], v[3]); *(u32x2*)((bf16_t*)(ws + O_XN) + o) = w; ss += v[0]*v[0] + v[1]*v[1] + v[2]*v[2] + v[3]*v[3]; }
          ss = wave_sum(ss);
          if (lane == 0) ssq[DBG_COPY * T + row] = ss;
      }
    }
#endif
    if (PHON(8) && p.ph_lo <= 8 && 8 < p.ph_hi) { if (8 > p.ph_lo) xcd_barrier(xb);
            FXq f{(bf16_t*)(ws + O_QX), ssq + 2 * T};
            run_gemm(lds, (const bf16_t*)(ws + O_XN), (const bf16_t*)(ws + O_WXQ), T, 512, 2048, f, 0);
    }
    if (PHON(9) && p.ph_lo <= 9 && 9 < p.ph_hi) { if (9 > p.ph_lo) xcd_barrier(xb);
            for (int it = blockIdx.x; it < 512; it += gridDim.x) { const int qt = it >> 4, bh = it & 15, b = bh >> 2, hd = bh & 3;
                attn_mha_item<128, 128, 4>(lds, (const bf16_t*)(ws + O_QX) + ((size_t)b * SEQ * 4 + hd) * 128, 512, (const bf16_t*)(ws + O_KMEM) + ((size_t)b * MEM * 4 + hd) * 128, 512,
                                           (const bf16_t*)(ws + O_VMEM) + ((size_t)b * MEM * 4 + hd) * 128, 512, (bf16_t*)(ws + O_OX) + (size_t)b * SEQ * 512 + hd * 128, 512, qt * 256, 3,
                                           0.08838834764831845f * 1.4426950408889634f); }
    }
    if (PHON(10) && p.ph_lo <= 10 && 10 < p.ph_hi) { if (10 > p.ph_lo) xcd_barrier(xb);
            FResid<1> f{nullptr, p.out, (bf16_t*)(ws + O_XN), ssq + 3 * T};
            run_gemm(lds, (const bf16_t*)(ws + O_OX), (const bf16_t*)(ws + O_WXO), T, 2048, 512, f, 0);
    }
#if defined(DBG_COPY) && DBG_COPY == 3
    { grid.sync();
      const int lane = threadIdx.x & 63;
      for (int row = gwave; row < T; row += nwave) {
          float ss = 0.f;
#pragma unroll
          for (int i = 0; i < 8; ++i) { const size_t o = (size_t)row * 2048 + (i * 64 + lane) * 4; const f32x4 v = *(const f32x4*)(p.x + o); *(f32x4*)(p.out + o) = v;
              u32x2 w; w.x = pk2(v[0], v[1]); w.y = pk2(v[2], v[3]); *(u32x2*)((bf16_t*)(ws + O_XN) + o) = w; ss += v[0]*v[0] + v[1]*v[1] + v[2]*v[2] + v[3]*v[3]; }
          ss = wave_sum(ss);
          if (lane == 0) ssq[DBG_COPY * T + row] = ss;
      }
    }
#endif
    if (PHON(11) && p.ph_lo <= 11 && 11 < p.ph_hi) { if (11 > p.ph_lo) xcd_barrier(xb);
            FFf1 f{(bf16_t*)(ws + O_U), ssq + 3 * T};
            run_gemm(lds, (const bf16_t*)(ws + O_XN), (const bf16_t*)(ws + O_WFF1), T, 8192, 2048, f, 0);
    }
    if (PHON(12) && p.ph_lo <= 12 && 12 < p.ph_hi) { if (12 > p.ph_lo) xcd_barrier(xb);
            FResid<1> f{nullptr, p.out, (bf16_t*)(ws + O_XN), ssq + 4 * T};
            run_gemm(lds, (const bf16_t*)(ws + O_U), (const bf16_t*)(ws + O_WFF2), T, 2048, 8192, f, 0);
    }
    if (PHON(13) && p.ph_lo <= 13 && 13 < p.ph_hi) { if (13 > p.ph_lo) xcd_barrier(xb);
            const int lane = threadIdx.x & 63;
            for (int row = gwave; row < T; row += nwave) {
                const float rs = rsqrtf(ssq[4 * T + row] * (1.f / 2048.f) + EPS);
#pragma unroll
                for (int i = 0; i < 8; ++i) { float* op = p.out + (size_t)row * 2048 + (i * 64 + lane) * 4; const u32x2 hw = *(const u32x2*)((const bf16_t*)(ws + O_XN) + (size_t)row * 2048 + (i * 64 + lane) * 4);
                    const f32x4 v = (f32x4){bf2f(hw.x & 0xffffu), bf2f(hw.x >> 16), bf2f(hw.y & 0xffffu), bf2f(hw.y >> 16)}; const f32x4 gv = *(const f32x4*)(p.g_final + (i * 64 + lane) * 4);
                    *(f32x4*)op = (f32x4){v[0] * rs * gv[0], v[1] * rs * gv[1], v[2] * rs * gv[2], v[3] * rs * gv[3]}; }
            }
#ifdef DBG_PROBE
            grid.sync(); if (blockIdx.x == 0 && threadIdx.x == 0) p.out[0] = ((const float*)(ws + O_BIASK))[200];
#endif
    }
}

constexpr int NPHASES = 14;
#ifndef MK_MULTI
#define MK_MULTI 0
#endif

extern "C" void kernel_launch(void* const* d_in, const int* in_sizes, int n_in, void* d_out, int out_size, void* d_ws, size_t ws_size, hipStream_t stream) {
    static int grid = 0;
    if (grid == 0) {
        if (n_in != 27 || ws_size < O_END2) { fprintf(stderr, "kernel_launch: unexpected n_in %d / ws %zu (need %zu)\n", n_in, ws_size, (size_t)O_END2); grid = -1; return; }
        int dev = 0, cus = 0, per_cu = 0;
        hipGetDevice(&dev);
        hipDeviceGetAttribute(&cus, hipDeviceAttributeMultiprocessorCount, dev);
        if (hipFuncSetAttribute((const void*)fwd_megakernel, hipFuncAttributeMaxDynamicSharedMemorySize, LDS_BYTES) != hipSuccess) { fprintf(stderr, "kernel_launch: hipFuncSetAttribute failed\n"); grid = -1; return; }
        if (hipOccupancyMaxActiveBlocksPerMultiprocessor(&per_cu, (const void*)fwd_megakernel, NTHREADS, LDS_BYTES) != hipSuccess || per_cu < 1) { fprintf(stderr, "kernel_launch: occupancy query gave %d\n", per_cu); per_cu = 1; }
        (void)hipGetLastError();
        grid = cus * per_cu;
    }
    if (grid < 0) return;
    Params p{};
    const float** pp = (const float**)&p;
    for (int i = 0; i < 27; ++i) pp[i] = (const float*)d_in[i];
    p.out = (float*)d_out; p.ws = (unsigned char*)d_ws;
#if MK_MULTI
    for (int ph = 0; ph < NPHASES; ++ph) {
        p.ph_lo = ph; p.ph_hi = ph + 1;
        hipLaunchKernelGGL(fwd_megakernel, dim3(grid), dim3(NTHREADS), LDS_BYTES, stream, p);
    }
#else
    (void)hipMemsetAsync((char*)d_ws + O_BAR, 0, (size_t)XCD_BAR_WORDS * 4, stream);
    p.ph_lo = 0; p.ph_hi = NPHASES;
    void* args[] = {&p};
    hipError_t e = hipLaunchCooperativeKernel((const void*)fwd_megakernel, dim3(grid), dim3(NTHREADS), args, LDS_BYTES, stream);
    if (e != hipSuccess) fprintf(stderr, "cooperative launch failed: %s (grid %d)\n", hipGetErrorString(e), grid);
#endif
}
```

```cpp
#include <hip/hip_runtime.h>
#include <hip/hip_cooperative_groups.h>
#include <cstdio>
namespace cg = cooperative_groups;

#define LAS __attribute__((address_space(3)))
#define DI __device__ __forceinline__
typedef unsigned short bf16_t;
typedef short bf16x8 __attribute__((ext_vector_type(8)));
typedef short s16x4 __attribute__((ext_vector_type(4)));
typedef float f32x4 __attribute__((ext_vector_type(4)));
typedef float f32x16 __attribute__((ext_vector_type(16)));
typedef unsigned u32x4 __attribute__((ext_vector_type(4)));
typedef unsigned u32x2 __attribute__((ext_vector_type(2)));

constexpr int SEQ = 8192, BATCH = 4, T = BATCH * SEQ, DM = 2048, DFF = 8192, MEM = 256;
constexpr int DIN = 8400;
constexpr float EPS = 1e-6f;
constexpr int NTHREADS = 512;
constexpr int LDS_BYTES = 131072;

constexpr size_t al256(size_t x) { return (x + 255) & ~(size_t)255; }
constexpr size_t O_WIN = 0;
constexpr size_t O_WG = O_WIN + (size_t)4352 * 2048 * 2;
constexpr size_t O_WUQ = O_WG + (size_t)4096 * 2048 * 2;
constexpr size_t O_WUK = O_WUQ + (size_t)1536 * 512 * 2;
constexpr size_t O_WUV = O_WUK + (size_t)1024 * 256 * 2;
constexpr size_t O_W1K = O_WUV + (size_t)1024 * 256 * 2;
constexpr size_t O_W1V = O_W1K + (size_t)96 * 3072 * 2;
constexpr size_t O_W2K = O_W1V + (size_t)64 * 2048 * 2;
constexpr size_t O_W2V = al256(O_W2K + 96 * 96 * 2);
constexpr size_t O_WONA = al256(O_W2V + 64 * 64 * 2);
constexpr size_t O_WONB = O_WONA + (size_t)2048 * 1024 * 2;
constexpr size_t O_WOUT = O_WONB + (size_t)2048 * 1024 * 2;
constexpr size_t O_WXQ = O_WOUT + (size_t)2048 * 2048 * 2;
constexpr size_t O_WXKV = O_WXQ + (size_t)512 * 2048 * 2;
constexpr size_t O_WXO = O_WXKV + (size_t)1024 * 2048 * 2;
constexpr size_t O_WFF1 = O_WXO + (size_t)2048 * 512 * 2;
constexpr size_t O_WFF2 = O_WFF1 + (size_t)8192 * 2048 * 2;
constexpr size_t O_BIASK = O_WFF2 + (size_t)2048 * 8192 * 2;
constexpr size_t O_COSA = al256(O_BIASK + 1024);
constexpr size_t O_SINA = O_COSA + (size_t)SEQ * 12 * 4;
constexpr size_t O_COSB = O_SINA + (size_t)SEQ * 12 * 4;
constexpr size_t O_SINB = O_COSB + (size_t)SEQ * 16 * 4;
constexpr size_t O_SSQ = O_SINB + (size_t)SEQ * 16 * 4;
constexpr size_t O_MEMN = O_SSQ + (size_t)5 * T * 4;
constexpr size_t O_KMEM = O_MEMN + (size_t)1024 * 2048 * 2;
constexpr size_t O_VMEM = O_KMEM + (size_t)1024 * 512 * 2;
constexpr size_t O_KCC = O_VMEM + (size_t)1024 * 512 * 2;
constexpr size_t O_VCC = O_KCC + (size_t)4 * 512 * 4 * 96 * 2;
constexpr size_t O_HK = O_VCC + (size_t)4 * 512 * 4 * 64 * 2;
constexpr size_t O_HV = O_HK + (size_t)8192 * 96 * 2;
constexpr size_t O_SEL = O_HV + (size_t)8192 * 64 * 2;
constexpr size_t O_GN = O_SEL + (size_t)T * 4 * 16;
constexpr size_t O_XN = al256(O_GN + (size_t)T * 48 * 4);
constexpr size_t O_OACC = O_XN + (size_t)T * 2048 * 2;
constexpr size_t O_OB = O_OACC + (size_t)T * 1024 * 4;
constexpr size_t O_R = O_OB + (size_t)T * 1024 * 2;
constexpr size_t O_QA = O_R;
constexpr size_t O_KS = O_QA + (size_t)T * 1536 * 2;
constexpr size_t O_VS = O_KS + (size_t)T * 384 * 2;
constexpr size_t O_KC = O_VS + (size_t)T * 256 * 2;
constexpr size_t O_KW = O_KC + (size_t)T * 384 * 2;
constexpr size_t O_VC = O_KW + (size_t)T * 384 * 2;
constexpr size_t O_VW = O_VC + (size_t)T * 256 * 2;
constexpr size_t O_CQ = O_VW + (size_t)T * 256 * 2;
constexpr size_t O_CKV = O_CQ + (size_t)T * 512 * 2;
constexpr size_t O_QMLA = O_CKV + (size_t)T * 256 * 2;
constexpr size_t O_KMLA = O_QMLA + (size_t)T * 1536 * 2;
constexpr size_t O_VMLA = O_KMLA + (size_t)T * 1536 * 2;
constexpr size_t O_END = O_VMLA + (size_t)T * 1024 * 2;
constexpr size_t O_OA = O_KC;
constexpr size_t O_GATES = O_QMLA;
constexpr size_t O_MIXED = O_QA;
constexpr size_t O_QX = O_KC;
constexpr size_t O_OX = O_KC + (size_t)T * 512 * 2;
constexpr size_t O_U = O_R;
static_assert(O_GATES + (size_t)T * 4096 * 2 <= O_END, "gates alias");
static_assert(O_U + (size_t)T * 8192 * 2 <= O_END, "u alias");
constexpr size_t O_BAR = O_END;
constexpr int XCD_BAR_WORDS = 3456;
constexpr size_t O_END2 = O_BAR + (size_t)XCD_BAR_WORDS * 4;
static_assert(O_END2 <= (size_t)1073741824, "workspace");

struct Params {
    const float *x, *mem, *g_mix, *w_in, *cmp_pos_k, *cmp_w1_k, *cmp_w2_k, *cmp_pos_v, *cmp_w1_v, *cmp_w2_v,
        *mla_g_q, *mla_w_uq, *mla_g_kv, *mla_w_uk, *mla_w_uv, *w_o_nsa, *w_o_mla, *w_out, *g_xattn, *g_mem,
        *xa_wq, *xa_wkv, *xa_wo, *g_mlp, *w_ff1, *w_ff2, *g_final;
    float* out;
    unsigned char* ws;
    int ph_lo, ph_hi;
};

DI float bf2f(unsigned b) { return __uint_as_float(b << 16); }
typedef float f32x2_t __attribute__((ext_vector_type(2)));
typedef __bf16 bf16x2_t __attribute__((ext_vector_type(2)));
DI unsigned pk2(float lo, float hi) { const f32x2_t v = {lo, hi}; return __builtin_bit_cast(unsigned, __builtin_convertvector(v, bf16x2_t)); }
DI bf16_t f2bf(float f) { return (bf16_t)(pk2(f, 0.f) & 0xffffu); }
DI float ex2(float x) { return __builtin_amdgcn_exp2f(x); }
DI float sigm(float x) { return __builtin_amdgcn_rcpf(1.f + __builtin_amdgcn_exp2f(-1.4426950408889634f * x)); }
DI float wave_sum(float v) {
#pragma unroll
    for (int o = 32; o > 0; o >>= 1) v += __shfl_xor(v, o);
    return v;
}
DI int permNSA(int p) { return p < 24 ? ((p & 1) ? 12 + (p >> 1) : (p >> 1)) : p; }
DI int permMLA(int p) { return (p & 1) ? 16 + (p >> 1) : (p >> 1); }
DI u32x4 pack8(f32x4 a, f32x4 b) { u32x4 w; w.x = pk2(a[0], a[1]); w.y = pk2(a[2], a[3]); w.z = pk2(b[0], b[1]); w.w = pk2(b[2], b[3]); return w; }
DI void unpack8(u32x4 w, f32x4& a, f32x4& b) {
    a[0] = bf2f(w.x & 0xffffu); a[1] = bf2f(w.x >> 16); a[2] = bf2f(w.y & 0xffffu); a[3] = bf2f(w.y >> 16);
    b[0] = bf2f(w.z & 0xffffu); b[1] = bf2f(w.z >> 16); b[2] = bf2f(w.w & 0xffffu); b[3] = bf2f(w.w >> 16);
}
DI void rope8(f32x4& a, f32x4& b, f32x4 c, f32x4 s) {
    float o0 = a[0] * c[0] - a[1] * s[0], o1 = a[0] * s[0] + a[1] * c[0];
    float o2 = a[2] * c[1] - a[3] * s[1], o3 = a[2] * s[1] + a[3] * c[1];
    float o4 = b[0] * c[2] - b[1] * s[2], o5 = b[0] * s[2] + b[1] * c[2];
    float o6 = b[2] * c[3] - b[3] * s[3], o7 = b[2] * s[3] + b[3] * c[3];
    a[0] = o0; a[1] = o1; a[2] = o2; a[3] = o3; b[0] = o4; b[1] = o5; b[2] = o6; b[3] = o7;
}
DI float sumsq8(f32x4 a, f32x4 b) { return a[0]*a[0] + a[1]*a[1] + a[2]*a[2] + a[3]*a[3] + b[0]*b[0] + b[1]*b[1] + b[2]*b[2] + b[3]*b[3]; }

namespace pg8 {
constexpr int BM = 256, BK = 64, HALF = 128, HTB = HALF * BK * 2, STAGE_BYTES = 8 * HTB, NXCD = 8, WGM = 8;
DI int lds_byte(int r, int c) { const int st = (r >> 4) * 2 + (c >> 5), rr = r & 15, cc = c & 31, ob = rr * 64 + cc * 2; return st * 1024 + (ob ^ (((ob >> 9) & 1) << 5)); }
DI void stage_rc(int b, int& R, int& C) { const int st = b / 1024, sb = b % 1024, swz = sb ^ (((sb >> 9) & 1) << 5); R = (st >> 1) * 16 + swz / 64; C = (st & 1) * 32 + (swz % 64) / 2; }
DI int perm32(int rho) { const int n = rho >> 4, i = rho & 15; return 8 * (i >> 2) + 4 * n + (i & 3); }
struct Unit { int pm, pn; };
struct Gemm { const bf16_t* A; const bf16_t* Bt; int M, N, K; };
struct StaticOrder {
    int nM, nN, nwg, G, c;
    DI void init(int M, int N, int G_, int c_) { nM = M / BM; nN = N / BM; nwg = nM * nN; G = G_; c = c_; }
    DI bool next(int i, Unit& u) const {
        const long L = (long)i * G + c; if (L >= nwg) return false;
        int wgid = (int)L; { const int q = nwg / NXCD, r = nwg % NXCD, xcd = wgid % NXCD, off = wgid / NXCD; wgid = (xcd < r ? xcd * (q + 1) : r * (q + 1) + (xcd - r) * q) + off; }
        const int nig = WGM * nN, gid = wgid / nig, fm = gid * WGM, gsz = (nM - fm) < WGM ? (nM - fm) : WGM;
        u.pm = fm + ((wgid % nig) % gsz); u.pn = (wgid % nig) / gsz; return true;
    }
};

template <class Epi>
DI void gemm_phase(LAS unsigned char* lds, const Gemm g, const StaticOrder& S, const Epi& E) {
    const int tid = threadIdx.x, wid = __builtin_amdgcn_readfirstlane(tid >> 6), lane = tid & 63, wr = wid >> 2, wc = wid & 3, fr = lane & 15, fq = lane >> 4;
    const int K = g.K, nt = K / BK;
    unsigned voffA[2], voffB[2];
#pragma unroll
    for (int i = 0; i < 2; ++i) { int R, C; stage_rc(tid * 16 + i * 8192, R, C); const int Rb = (R & ~31) + perm32(R & 31);
        voffA[i] = (unsigned)(R * K + C) * 2u; voffB[i] = (unsigned)(Rb * K + C) * 2u; }
    const size_t kstep = (size_t)(BK * 2);
    const size_t hstep = (size_t)HALF * K * 2;
    const size_t tstep = 2 * hstep;
    const unsigned ldsw = (unsigned)wid * 1024u;
    const int aoff = lds_byte(wr * 64 + fr, fq * 8), boff = lds_byte(wc * 32 + fr, fq * 8);
#define PG8_SA(b, h) (((b) * 2 + (h)) * HTB)
#define PG8_SB(b, h) ((4 + (b) * 2 + (h)) * HTB)
#define PG8_STAGE(bufoff, gbase, voff) do { _Pragma("unroll") for (int _i = 0; _i < 2; ++_i) \
        __builtin_amdgcn_global_load_lds((const unsigned*)((const char*)(gbase) + (voff)[_i]), (LAS unsigned*)(lds + (bufoff) + ldsw + _i * 8192), 16, 0, 0); } while (0)
#define PG8_LDA(dst, b, h) do { _Pragma("unroll") for (int m = 0; m < 4; ++m) _Pragma("unroll") for (int k = 0; k < 2; ++k) dst[m][k] = *(const LAS bf16x8*)(lds + PG8_SA(b, h) + aoff + m * 2048 + k * 1024); } while (0)
#define PG8_LDB(dst, b, h) do { _Pragma("unroll") for (int n = 0; n < 2; ++n) _Pragma("unroll") for (int k = 0; k < 2; ++k) dst[n][k] = *(const LAS bf16x8*)(lds + PG8_SB(b, h) + boff + n * 2048 + k * 1024); } while (0)
#define PG8_MMA(ai, bj, At, Bt) do { __builtin_amdgcn_s_setprio(1); _Pragma("unroll") for (int m = 0; m < 4; ++m) _Pragma("unroll") for (int n = 0; n < 2; ++n) _Pragma("unroll") for (int k = 0; k < 2; ++k) \
        acc[ai][bj][m][n] = __builtin_amdgcn_mfma_f32_16x16x32_bf16(Bt[n][k], At[m][k], acc[ai][bj][m][n], 0, 0, 0); __builtin_amdgcn_s_setprio(0); } while (0)
#define PG8_WAIT_V(n) asm volatile("s_waitcnt vmcnt(" #n ")" ::: "memory")
#define PG8_WAIT_L(n) asm volatile("s_waitcnt lgkmcnt(" #n ")" ::: "memory")
#define PG8_BAR __builtin_amdgcn_s_barrier()
#define PG8_SCHED __builtin_amdgcn_sched_barrier(0)
    Unit cur, nxt; int ui = 0;
    if (!S.next(0, cur)) return;
    f32x4 acc[2][2][4][2];
#pragma unroll
    for (int a = 0; a < 2; ++a)
#pragma unroll
        for (int b = 0; b < 2; ++b)
#pragma unroll
            for (int m = 0; m < 4; ++m)
#pragma unroll
                for (int n = 0; n < 2; ++n) acc[a][b][m][n] = (f32x4){0.f, 0.f, 0.f, 0.f};
    bf16x8 At[4][2], B0[2][2], B1[2][2];
    const char* cA = (const char*)g.A + (size_t)cur.pm * tstep; const char* cB = (const char*)g.Bt + (size_t)cur.pn * tstep;
    PG8_STAGE(PG8_SB(0, 0), cB, voffB); PG8_STAGE(PG8_SA(0, 0), cA, voffA); PG8_STAGE(PG8_SB(0, 1), cB + hstep, voffB); PG8_STAGE(PG8_SA(0, 1), cA + hstep, voffA);
    if (wr == 1) PG8_BAR;
    PG8_WAIT_V(4); PG8_BAR;
    PG8_STAGE(PG8_SB(1, 0), cB + kstep, voffB); PG8_STAGE(PG8_SA(1, 0), cA + kstep, voffA); PG8_STAGE(PG8_SB(1, 1), cB + hstep + kstep, voffB);
    PG8_WAIT_V(6); PG8_BAR;
    for (;;) {
        const bool has_next = S.next(ui + 1, nxt);
        const char* nA = has_next ? (const char*)g.A + (size_t)nxt.pm * tstep : cA; const char* nB = has_next ? (const char*)g.Bt + (size_t)nxt.pn * tstep : cB;
#pragma unroll 1
        for (int t = 0; t < nt; t += 2) {
            const bool last = (t == nt - 2);
            const char* a1 = cA + (size_t)(t + 1) * kstep;
            const char* a2 = last ? nA : cA + (size_t)(t + 2) * kstep; const char* b2 = last ? nB : cB + (size_t)(t + 2) * kstep;
            const char* a3 = a2 + kstep; const char* b3 = b2 + kstep;
            PG8_LDB(B0, 0, 0); PG8_SCHED; PG8_LDA(At, 0, 0); PG8_STAGE(PG8_SA(1, 1), a1 + hstep, voffA);
            PG8_WAIT_L(8); PG8_BAR; PG8_WAIT_L(0); PG8_MMA(0, 0, At, B0); PG8_BAR; PG8_SCHED;
            PG8_LDB(B1, 0, 1); PG8_STAGE(PG8_SB(0, 0), b2, voffB);
            PG8_BAR; PG8_WAIT_L(0); PG8_MMA(0, 1, At, B1); PG8_BAR;
            PG8_LDA(At, 0, 1); PG8_STAGE(PG8_SA(0, 0), a2, voffA);
            PG8_BAR; PG8_WAIT_L(0); PG8_MMA(1, 0, At, B0); PG8_BAR; PG8_SCHED;
            PG8_STAGE(PG8_SB(0, 1), b2 + hstep, voffB);
            PG8_WAIT_V(6); PG8_BAR; PG8_MMA(1, 1, At, B1); PG8_BAR;
            PG8_LDB(B0, 1, 0); PG8_SCHED; PG8_LDA(At, 1, 0); PG8_STAGE(PG8_SA(0, 1), a2 + hstep, voffA);
            PG8_WAIT_L(8); PG8_BAR; PG8_WAIT_L(0); PG8_MMA(0, 0, At, B0); PG8_BAR; PG8_SCHED;
            PG8_LDB(B1, 1, 1); PG8_STAGE(PG8_SB(1, 0), b3, voffB);
            PG8_BAR; PG8_WAIT_L(0); PG8_MMA(0, 1, At, B1); PG8_BAR;
            PG8_LDA(At, 1, 1); PG8_STAGE(PG8_SA(1, 0), a3, voffA);
            PG8_BAR; PG8_WAIT_L(0); PG8_MMA(1, 0, At, B0); PG8_BAR; PG8_SCHED;
            PG8_STAGE(PG8_SB(1, 1), b3 + hstep, voffB);
            PG8_WAIT_V(6); PG8_BAR; PG8_MMA(1, 1, At, B1); PG8_BAR;
        }
        E(acc, cur, wr, wc, fr, fq);
        if (!has_next) break;
#pragma unroll
        for (int a = 0; a < 2; ++a)
#pragma unroll
            for (int b = 0; b < 2; ++b)
#pragma unroll
                for (int m = 0; m < 4; ++m)
#pragma unroll
                    for (int n = 0; n < 2; ++n) acc[a][b][m][n] = (f32x4){0.f, 0.f, 0.f, 0.f};
        cur = nxt; cA = nA; cB = nB; ++ui;
    }
    PG8_WAIT_V(0);
    if (wr == 0) PG8_BAR;
    PG8_BAR;
#undef PG8_SA
#undef PG8_SB
#undef PG8_STAGE
#undef PG8_LDA
#undef PG8_LDB
#undef PG8_MMA
#undef PG8_WAIT_V
#undef PG8_WAIT_L
#undef PG8_BAR
#undef PG8_SCHED
}
}

struct NoPre {};
template <class F> struct EpiT {
    F f;
    DI void operator()(const f32x4 (&acc)[2][2][4][2], const pg8::Unit& u, int wr, int wc, int fr, int fq) const {
#pragma unroll
        for (int ai = 0; ai < 2; ++ai) {
            typename F::Pre pre[4][2];
#pragma unroll
            for (int m = 0; m < 4; ++m)
#pragma unroll
                for (int bj = 0; bj < 2; ++bj) pre[m][bj] = f.load(u.pm * 256 + ai * 128 + wr * 64 + m * 16 + fr, u.pn * 256 + bj * 128 + wc * 32 + 8 * fq);
#pragma unroll
            for (int m = 0; m < 4; ++m)
#pragma unroll
                for (int bj = 0; bj < 2; ++bj) f.apply(u.pm * 256 + ai * 128 + wr * 64 + m * 16 + fr, u.pn * 256 + bj * 128 + wc * 32 + 8 * fq, acc[ai][bj][m][0], acc[ai][bj][m][1], pre[m][bj]);
        }
    }
};
template <class F> DI void run_gemm(LAS unsigned char* lds, const bf16_t* A, const bf16_t* Bt, int M, int N, int K, const F& f, int rot) {
    pg8::Gemm g{A, Bt, M, N, K}; pg8::StaticOrder S; S.init(M, N, (int)gridDim.x, (int)((blockIdx.x + rot) % gridDim.x));
    EpiT<F> E{f};
    pg8::gemm_phase(lds, g, S, E);
}

struct FGemm1 {
    unsigned char* ws; int col0;
    typedef NoPre Pre; DI Pre load(int, int) const { return Pre{}; }
    DI void apply(int row, int gc0, f32x4 a, f32x4 b, const Pre&) const {
        const int gc = gc0 + col0;
        const int pos = row & (SEQ - 1);
        if (gc < 2688) {
            const int m = gc < 1536 ? gc : gc - 1536;
            const int p = m % 96;
            if (p < 24) rope8(a, b, *(const f32x4*)((const float*)(ws + O_COSA) + pos * 12 + (p >> 1)), *(const f32x4*)((const float*)(ws + O_SINA) + pos * 12 + (p >> 1)));
            size_t off;
            if (gc < 1536) off = O_QA + ((size_t)row * 1536 + gc) * 2;
            else { const int seg = m / 384, c = m % 384; off = (seg == 0 ? O_KC : (seg == 1 ? O_KS : O_KW)) + ((size_t)row * 384 + c) * 2; }
            *(u32x4*)(ws + off) = pack8(a, b);
        } else if (gc < 3456) {
            const int m = gc - 2688, seg = m >> 8, c = m & 255;
            const size_t off = (seg == 0 ? O_VC : (seg == 1 ? O_VS : O_VW)) + ((size_t)row * 256 + c) * 2;
            *(u32x4*)(ws + off) = pack8(a, b);
        } else if (gc < 3712) {
            *(u32x4*)(ws + O_CKV + ((size_t)row * 256 + (gc - 3456)) * 2) = pack8(a, b);
            float s = sumsq8(a, b); s += __shfl_xor(s, 16); s += __shfl_xor(s, 32);
            if ((threadIdx.x & 63) < 16) atomicAdd((float*)(ws + O_SSQ) + T + row, s);
        } else if (gc < 3744) {
            const int p = gc - 3712;
            rope8(a, b, *(const f32x4*)((const float*)(ws + O_COSB) + pos * 16 + (p >> 1)), *(const f32x4*)((const float*)(ws + O_SINB) + pos * 16 + (p >> 1)));
            const u32x4 w = pack8(a, b);
            bf16_t* d = (bf16_t*)(ws + O_KMLA) + (size_t)row * 1536 + 64 + p;
            for (int h = 0; h < 16; ++h) *(u32x4*)(d + h * 96) = w;
        } else if (gc < 3792) {
            float* d = (float*)(ws + O_GN) + (size_t)row * 48 + (gc - 3744);
            *(f32x4*)d = (f32x4){sigm(a[0]), sigm(a[1]), sigm(a[2]), sigm(a[3])};
            *(f32x4*)(d + 4) = (f32x4){sigm(b[0]), sigm(b[1]), sigm(b[2]), sigm(b[3])};
        } else if (gc >= 3840) {
            *(u32x4*)(ws + O_CQ + ((size_t)row * 512 + (gc - 3840)) * 2) = pack8(a, b);
            float s = sumsq8(a, b); s += __shfl_xor(s, 16); s += __shfl_xor(s, 32);
            if ((threadIdx.x & 63) < 16) atomicAdd((float*)(ws + O_SSQ) + row, s);
        }
    }
};
struct FMemKV { bf16_t *Km, *Vm;
    typedef NoPre Pre; DI Pre load(int, int) const { return Pre{}; }
    DI void apply(int row, int gc, f32x4 a, f32x4 b, const Pre&) const {
        bf16_t* d = gc < 512 ? Km + (size_t)row * 512 + gc : Vm + (size_t)row * 512 + (gc - 512);
        *(u32x4*)d = pack8(a, b); } };
struct FUq { unsigned char* ws;
    typedef float Pre; DI Pre load(int row, int) const { return ((const float*)(ws + O_SSQ))[row]; }
    DI void apply(int row, int gc, f32x4 a, f32x4 b, const Pre& pre) const {
        const float rs = rsqrtf(pre * (1.f / 512.f) + EPS); a *= rs; b *= rs;
        const int p = gc % 96, pos = row & (SEQ - 1);
        if (p >= 64) rope8(a, b, *(const f32x4*)((const float*)(ws + O_COSB) + pos * 16 + ((p - 64) >> 1)), *(const f32x4*)((const float*)(ws + O_SINB) + pos * 16 + ((p - 64) >> 1)));
        *(u32x4*)(ws + O_QMLA + ((size_t)row * 1536 + gc) * 2) = pack8(a, b); } };
struct FUkv { unsigned char* ws;
    typedef float Pre; DI Pre load(int row, int) const { return ((const float*)(ws + O_SSQ))[T + row]; }
    DI void apply(int row, int gc, f32x4 a, f32x4 b, const Pre& pre) const {
        const float rs = rsqrtf(pre * (1.f / 256.f) + EPS); a *= rs; b *= rs;
        const size_t off = gc < 1024 ? O_KMLA + ((size_t)row * 1536 + (gc >> 6) * 96 + (gc & 63)) * 2 : O_VMLA + ((size_t)row * 1024 + (gc - 1024)) * 2;
        *(u32x4*)(ws + off) = pack8(a, b); } };
struct FGate { bf16_t* g;
    typedef NoPre Pre; DI Pre load(int, int) const { return Pre{}; }
    DI void apply(int row, int gc, f32x4 a, f32x4 b, const Pre&) const {
#pragma unroll
        for (int i = 0; i < 4; ++i) { a[i] = sigm(a[i]); b[i] = sigm(b[i]); }
        *(u32x4*)(g + (size_t)row * 4096 + gc) = pack8(a, b); } };
template <int SECOND> struct FMix { const bf16_t* g; bf16_t* mixed;
    struct Pre { u32x4 g, mx; };
    DI Pre load(int row, int gc) const { Pre p; p.g = *(const u32x4*)(g + (size_t)row * 4096 + SECOND * 2048 + gc); if (SECOND) p.mx = *(const u32x4*)(mixed + (size_t)row * 2048 + gc); return p; }
    DI void apply(int row, int gc, f32x4 a, f32x4 b, const Pre& pre) const {
        f32x4 ga, gb; unpack8(pre.g, ga, gb);
        a *= ga; b *= gb;
        if (SECOND) { f32x4 pa, pb; unpack8(pre.mx, pa, pb); a += pa; b += pb; }
        *(u32x4*)(mixed + (size_t)row * 2048 + gc) = pack8(a, b); } };
template <int MODE> struct FResid { const float* base; float* out; bf16_t* hb; float* ssq;
    struct Pre { f32x4 a, b; u32x4 h; };
    DI Pre load(int row, int gc) const { Pre p;
        if (MODE == 0) { const float* bp = base + (size_t)row * 2048 + gc; p.a = *(const f32x4*)bp; p.b = *(const f32x4*)(bp + 4); }
        else p.h = *(const u32x4*)(hb + (size_t)row * 2048 + gc);
        return p; }
    DI void apply(int row, int gc, f32x4 a, f32x4 b, const Pre& pre) const {
        if (MODE == 0) { a += pre.a; b += pre.b; }
        else { f32x4 pa, pb; unpack8(pre.h, pa, pb); a += pa; b += pb; }
        if (MODE == 2) { float* op = out + (size_t)row * 2048 + gc; *(f32x4*)op = a; *(f32x4*)(op + 4) = b; }
        else *(u32x4*)(hb + (size_t)row * 2048 + gc) = pack8(a, b);
        float s = sumsq8(a, b); s += __shfl_xor(s, 16); s += __shfl_xor(s, 32);
        if ((threadIdx.x & 63) < 16) atomicAdd(ssq + row, s); } };
struct FXq { bf16_t* q; const float* ssq;
    typedef float Pre; DI Pre load(int row, int) const { return ssq[row]; }
    DI void apply(int row, int gc, f32x4 a, f32x4 b, const Pre& pre) const {
        const float rs = rsqrtf(pre * (1.f / 2048.f) + EPS); a *= rs; b *= rs;
        *(u32x4*)(q + (size_t)row * 512 + gc) = pack8(a, b); } };
struct FFf1 { bf16_t* u; const float* ssq;
    typedef float Pre; DI Pre load(int row, int) const { return ssq[row]; }
    DI void apply(int row, int gc, f32x4 a, f32x4 b, const Pre& pre) const {
        const float rs = rsqrtf(pre * (1.f / 2048.f) + EPS);
#pragma unroll
        for (int i = 0; i < 4; ++i) { float z = fmaxf(a[i] * rs, 0.f); a[i] = z * z; z = fmaxf(b[i] * rs, 0.f); b[i] = z * z; }
        *(u32x4*)(u + (size_t)row * 8192 + gc) = pack8(a, b); } };

template <int NMAP> DI int nmap(int n) {
    if (NMAP == 0) return n;
    if (NMAP == 1) {
        if (n < 1536) { const int h = n / 96, p = n % 96; return h * 96 + permNSA(p); }
        if (n < 2688) { const int m = n - 1536, seg = m / 384, c = m % 384, hh = c / 96, p = c % 96; const int sb = seg == 0 ? 1536 : (seg == 1 ? 2176 : 2816); return sb + hh * 96 + permNSA(p); }
        if (n < 3456) { const int m = n - 2688, seg = m >> 8, c = m & 255; const int sb = seg == 0 ? 1920 : (seg == 1 ? 2560 : 3200); return sb + c; }
        if (n < 3712) return 4016 + (n - 3456);
        if (n < 3744) return 4272 + permMLA(n - 3712);
        if (n < 3792) return 3456 + (n - 3744);
        if (n < 3840) return -1;
        return 3504 + (n - 3840);
    }
    if (NMAP == 2) { const int h = n / 96, p = n % 96; return p < 64 ? n : h * 96 + 64 + permMLA(p - 64); }
    return n;
}
template <int KMAP> DI int kmap(int k) { if (KMAP == 1) { const int l = k / 96, p = k % 96; return l * 96 + permNSA(p); } return k; }

template <int NMAP, int KMAP>
DI void transpose_w(const float* __restrict__ src, int ldsrc, int K, bf16_t* __restrict__ dst, int Ndst, const float* __restrict__ kscale, LAS float* tile) {
    const int tn = (Ndst + 63) / 64, tk = K / 64, ntiles = tn * tk;
    if (NMAP == 0 && KMAP == 0) {
        for (int t = blockIdx.x; t < ntiles; t += gridDim.x) {
            const int in = t % tn, ik = t / tn;
#pragma unroll
            for (int i = 0; i < 2; ++i) { const int e = threadIdx.x + i * NTHREADS, kk = e >> 4, n4 = (e & 15) * 4, k = ik * 64 + kk, n = in * 64 + n4;
                f32x4 v = (f32x4){0.f, 0.f, 0.f, 0.f};
                if (n < Ndst) v = *(const f32x4*)(src + (size_t)k * ldsrc + n);
                if (kscale) v *= kscale[k];
                tile[kk * 65 + n4] = v[0]; tile[kk * 65 + n4 + 1] = v[1]; tile[kk * 65 + n4 + 2] = v[2]; tile[kk * 65 + n4 + 3] = v[3]; }
            __syncthreads();
            { const int nn = threadIdx.x >> 3, k8 = (threadIdx.x & 7) * 8, n = in * 64 + nn;
              u32x4 w; w.x = pk2(tile[(k8 + 0) * 65 + nn], tile[(k8 + 1) * 65 + nn]); w.y = pk2(tile[(k8 + 2) * 65 + nn], tile[(k8 + 3) * 65 + nn]);
              w.z = pk2(tile[(k8 + 4) * 65 + nn], tile[(k8 + 5) * 65 + nn]); w.w = pk2(tile[(k8 + 6) * 65 + nn], tile[(k8 + 7) * 65 + nn]);
              if (n < Ndst) *(u32x4*)(dst + (size_t)n * K + ik * 64 + k8) = w; }
            __syncthreads();
        }
        return;
    }
    for (int t = blockIdx.x; t < ntiles; t += gridDim.x) {
        const int in = t % tn, ik = t / tn;
        for (int e = threadIdx.x; e < 4096; e += NTHREADS) {
            const int kk = e >> 6, nn = e & 63, n = in * 64 + nn, k = ik * 64 + kk;
            const int sc = (n < Ndst) ? nmap<NMAP>(n) : -1;
            const int sr = kmap<KMAP>(k);
            float v = (sc >= 0) ? src[(size_t)sr * ldsrc + sc] : 0.f;
            if (kscale) v *= kscale[sr];
            tile[kk * 65 + nn] = v;
        }
        __syncthreads();
        for (int e = threadIdx.x; e < 2048; e += NTHREADS) {
            const int nn = e >> 5, k2 = (e & 31) * 2, n = in * 64 + nn;
            if (n < Ndst) *(unsigned*)(dst + (size_t)n * K + ik * 64 + k2) = pk2(tile[k2 * 65 + nn], tile[(k2 + 1) * 65 + nn]);
        }
        __syncthreads();
    }
}

DI void rmsnorm_rows(const float* __restrict__ src, const float* __restrict__ g, bf16_t* __restrict__ dst, int nrows) {
    const int lane = threadIdx.x & 63, gw = blockIdx.x * (NTHREADS / 64) + (threadIdx.x >> 6), nw = gridDim.x * (NTHREADS / 64);
    for (int row = gw; row < nrows; row += nw) {
        f32x4 v[8]; float ss = 0.f;
#pragma unroll
        for (int i = 0; i < 8; ++i) { v[i] = *(const f32x4*)(src + (size_t)row * 2048 + (i * 64 + lane) * 4); ss += v[i][0] * v[i][0] + v[i][1] * v[i][1] + v[i][2] * v[i][2] + v[i][3] * v[i][3]; }
        ss = wave_sum(ss);
        const float rs = rsqrtf(ss * (1.f / 2048.f) + EPS);
#pragma unroll
        for (int i = 0; i < 8; ++i) { const f32x4 gv = *(const f32x4*)(g + (i * 64 + lane) * 4);
            u32x2 w; w.x = pk2(v[i][0] * rs * gv[0], v[i][1] * rs * gv[1]); w.y = pk2(v[i][2] * rs * gv[2], v[i][3] * rs * gv[3]);
            *(u32x2*)(dst + (size_t)row * 2048 + (i * 64 + lane) * 4) = w; }
    }
}

DI void phase_prep(const Params& p, LAS unsigned char* lds) {
    unsigned char* ws = p.ws;
    LAS float* tile = (LAS float*)lds;
    const int gtid = blockIdx.x * NTHREADS + threadIdx.x, gsz = gridDim.x * NTHREADS;
    { float* z = (float*)(ws + O_SSQ); for (int i = gtid; i < 5 * T; i += gsz) z[i] = 0.f; }
    { float *cA = (float*)(ws + O_COSA), *sA = (float*)(ws + O_SINA), *cB = (float*)(ws + O_COSB), *sB = (float*)(ws + O_SINB);
      for (int i = gtid; i < SEQ * 12; i += gsz) { const int pos = i / 12, j = i % 12; const float inv = 1.0f / powf(500000.0f, (float)(2 * j) / 24.0f); const float ang = (float)pos * inv; cA[i] = cosf(ang); sA[i] = sinf(ang); }
      for (int i = gtid; i < SEQ * 16; i += gsz) { const int pos = i / 16, j = i % 16; const float inv = 1.0f / powf(500000.0f, (float)(2 * j) / 32.0f); const float ang = (float)pos * inv; cB[i] = cosf(ang); sB[i] = sinf(ang); } }
    if (blockIdx.x == 1 % gridDim.x) {
        const int n = threadIdx.x & 127, part = threadIdx.x >> 7;
        float s = 0.f;
        if (n < 96) for (int k = part * 768; k < (part + 1) * 768; ++k) s += p.cmp_pos_k[k] * p.cmp_w1_k[(size_t)k * 96 + n];
        tile[threadIdx.x] = s; __syncthreads();
        if (threadIdx.x < 96) ((float*)(ws + O_BIASK))[threadIdx.x] = tile[threadIdx.x] + tile[threadIdx.x + 128] + tile[threadIdx.x + 256] + tile[threadIdx.x + 384];
        __syncthreads();
        s = 0.f;
        if (n < 64) for (int k = part * 512; k < (part + 1) * 512; ++k) s += p.cmp_pos_v[k] * p.cmp_w1_v[(size_t)k * 64 + n];
        tile[threadIdx.x] = s; __syncthreads();
        if (threadIdx.x < 64) ((float*)(ws + O_BIASK))[96 + threadIdx.x] = tile[threadIdx.x] + tile[threadIdx.x + 128] + tile[threadIdx.x + 256] + tile[threadIdx.x + 384];
        __syncthreads();
    }
    if (blockIdx.x == 2 % gridDim.x) {
        bf16_t* w2k = (bf16_t*)(ws + O_W2K); bf16_t* w2v = (bf16_t*)(ws + O_W2V);
        for (int e = threadIdx.x; e < 96 * 96; e += NTHREADS) { const int n = e / 96, k = e % 96; w2k[e] = f2bf(p.cmp_w2_k[k * 96 + permNSA(n)]); }
        for (int e = threadIdx.x; e < 64 * 64; e += NTHREADS) { const int n = e >> 6, k = e & 63; w2v[e] = f2bf(p.cmp_w2_v[k * 64 + n]); }
    }
    rmsnorm_rows(p.x, p.g_mix, (bf16_t*)(ws + O_XN), T);
    rmsnorm_rows(p.mem, p.g_mem, (bf16_t*)(ws + O_MEMN), BATCH * MEM);
    transpose_w<1, 0>(p.w_in, DIN, 2048, (bf16_t*)(ws + O_WIN), 4352, nullptr, tile);
    transpose_w<0, 0>(p.w_in + 4304, DIN, 2048, (bf16_t*)(ws + O_WG), 4096, nullptr, tile);
    transpose_w<2, 0>(p.mla_w_uq, 1536, 512, (bf16_t*)(ws + O_WUQ), 1536, p.mla_g_q, tile);
    transpose_w<0, 0>(p.mla_w_uk, 1024, 256, (bf16_t*)(ws + O_WUK), 1024, p.mla_g_kv, tile);
    transpose_w<0, 0>(p.mla_w_uv, 1024, 256, (bf16_t*)(ws + O_WUV), 1024, p.mla_g_kv, tile);
    transpose_w<0, 1>(p.cmp_w1_k, 96, 3072, (bf16_t*)(ws + O_W1K), 96, nullptr, tile);
    transpose_w<0, 0>(p.cmp_w1_v, 64, 2048, (bf16_t*)(ws + O_W1V), 64, nullptr, tile);
    transpose_w<0, 0>(p.w_o_nsa, 2048, 1024, (bf16_t*)(ws + O_WONA), 2048, nullptr, tile);
    transpose_w<0, 0>(p.w_o_mla, 2048, 1024, (bf16_t*)(ws + O_WONB), 2048, nullptr, tile);
    transpose_w<0, 0>(p.w_out, 2048, 2048, (bf16_t*)(ws + O_WOUT), 2048, nullptr, tile);
    transpose_w<0, 0>(p.xa_wq, 512, 2048, (bf16_t*)(ws + O_WXQ), 512, p.g_xattn, tile);
    transpose_w<0, 0>(p.xa_wkv, 1024, 2048, (bf16_t*)(ws + O_WXKV), 1024, nullptr, tile);
    transpose_w<0, 0>(p.xa_wo, 2048, 512, (bf16_t*)(ws + O_WXO), 2048, nullptr, tile);
    transpose_w<0, 0>(p.w_ff1, 8192, 2048, (bf16_t*)(ws + O_WFF1), 8192, p.g_mlp, tile);
    transpose_w<0, 0>(p.w_ff2, 2048, 8192, (bf16_t*)(ws + O_WFF2), 2048, nullptr, tile);
}

DI float gelu_tanh(float x) { const float u = 0.7978845608028654f * (x + 0.044715f * x * x * x); return 0.5f * x * (1.f + tanhf(u)); }

template <int DH> DI void compress_stage1(const bf16_t* __restrict__ X  , const bf16_t* __restrict__ W1t  , const float* __restrict__ bias, bf16_t* __restrict__ H, int task) {
    constexpr int NB = DH / 16, SPL = DH / 32;
    const int lane = threadIdx.x & 63, fr = lane & 15, fq = lane >> 4;
    const int bg = task >> 5, ct = task & 31, b = bg >> 2, g = bg & 3;
    int c = ct * 16 + fr; if (c > 510) c = 510;
    const bf16_t* arow = X + ((size_t)(b * SEQ + 16 * c) * 4 + g) * DH + 8 * fq;
    const bf16_t* brow = W1t + (size_t)fr * (32 * DH) + 8 * fq;
    f32x4 acc[NB];
#pragma unroll
    for (int n = 0; n < NB; ++n) acc[n] = (f32x4){0.f, 0.f, 0.f, 0.f};
    for (int l = 0; l < 32; ++l) {
#pragma unroll
        for (int s2 = 0; s2 < SPL; ++s2) {
            const bf16x8 a = *(const bf16x8*)(arow + (size_t)l * 4 * DH + s2 * 32);
            const int koff = l * DH + s2 * 32;
#pragma unroll
            for (int n = 0; n < NB; ++n) { const bf16x8 bb = *(const bf16x8*)(brow + (size_t)n * 16 * (32 * DH) + koff);
                acc[n] = __builtin_amdgcn_mfma_f32_16x16x32_bf16(a, bb, acc[n], 0, 0, 0); }
        }
    }
#pragma unroll
    for (int n = 0; n < NB; ++n)
#pragma unroll
        for (int j = 0; j < 4; ++j) { const int cc = ct * 16 + fq * 4 + j, col = n * 16 + fr;
            H[((size_t)(b * 512 + cc) * 4 + g) * DH + col] = f2bf(gelu_tanh(acc[n][j] + bias[col])); }
}
template <int DH> DI void compress_stage2(const bf16_t* __restrict__ H, const bf16_t* __restrict__ W2t  , bf16_t* __restrict__ O, int task) {
    constexpr int NB = DH / 16, KS = DH / 32;
    const int lane = threadIdx.x & 63, fr = lane & 15, fq = lane >> 4;
    const int bg = task >> 5, ct = task & 31, b = bg >> 2, g = bg & 3;
    int c = ct * 16 + fr; if (c > 510) c = 510;
    const bf16_t* arow = H + ((size_t)(b * 512 + c) * 4 + g) * DH + 8 * fq;
    f32x4 acc[NB];
#pragma unroll
    for (int n = 0; n < NB; ++n) acc[n] = (f32x4){0.f, 0.f, 0.f, 0.f};
#pragma unroll
    for (int s = 0; s < KS; ++s) { const bf16x8 a = *(const bf16x8*)(arow + s * 32);
#pragma unroll
        for (int n = 0; n < NB; ++n) { const bf16x8 bb = *(const bf16x8*)(W2t + (size_t)(n * 16 + fr) * DH + s * 32 + 8 * fq);
            acc[n] = __builtin_amdgcn_mfma_f32_16x16x32_bf16(a, bb, acc[n], 0, 0, 0); } }
#pragma unroll
    for (int n = 0; n < NB; ++n)
#pragma unroll
        for (int j = 0; j < 4; ++j) { const int cc = ct * 16 + fq * 4 + j, col = n * 16 + fr;
            O[((size_t)(b * 512 + cc) * 4 + g) * DH + col] = (cc > 510) ? (bf16_t)0 : f2bf(acc[n][j]); }
}

template <int DK, int DV> struct ALay {
    static constexpr int KSB = DK * 2 + 16, VSB = DV * 2 + 64;
    static constexpr int KBYTES = 64 * KSB, VBYTES = 64 * VSB, BUF = KBYTES + VBYTES;
    static constexpr int NPK = 64 * DK / 8, NPV = 64 * DV / 8;
    static constexpr int KI = (NPK + NTHREADS - 1) / NTHREADS, VI = (NPV + NTHREADS - 1) / NTHREADS;
};
constexpr int IMPS = 129;
constexpr int LDS_IMP = 77824, LDS_UNI = 77824 + 64 * 129 * 4 + 256;

template <int DK, int DV>
DI void tile_load(const bf16_t* __restrict__ Kt, int kstride, const bf16_t* __restrict__ Vt, int vstride, u32x4 (&kr)[ALay<DK, DV>::KI], u32x4 (&vr)[ALay<DK, DV>::VI]) {
    using L = ALay<DK, DV>;
#pragma unroll
    for (int i = 0; i < L::KI; ++i) { const int pi = threadIdx.x + i * NTHREADS; if (pi < L::NPK) { const int row = pi / (DK / 8), ch = pi % (DK / 8); kr[i] = *(const u32x4*)(Kt + (size_t)row * kstride + ch * 8); } }
#pragma unroll
    for (int i = 0; i < L::VI; ++i) { const int pi = threadIdx.x + i * NTHREADS; if (pi < L::NPV) { const int row = pi / (DV / 8), ch = pi % (DV / 8); vr[i] = *(const u32x4*)(Vt + (size_t)row * vstride + ch * 8); } }
}
template <int DK, int DV>
DI void tile_store(LAS unsigned char* kb, const u32x4 (&kr)[ALay<DK, DV>::KI], const u32x4 (&vr)[ALay<DK, DV>::VI]) {
    using L = ALay<DK, DV>;
#pragma unroll
    for (int i = 0; i < L::KI; ++i) { const int pi = threadIdx.x + i * NTHREADS; if (pi < L::NPK) { const int row = pi / (DK / 8), ch = pi % (DK / 8); *(LAS u32x4*)(kb + row * L::KSB + ch * 16) = kr[i]; } }
#pragma unroll
    for (int i = 0; i < L::VI; ++i) { const int pi = threadIdx.x + i * NTHREADS; if (pi < L::NPV) { const int row = pi / (DV / 8), ch = pi % (DV / 8); *(LAS u32x4*)(kb + L::KBYTES + row * L::VSB + ch * 16) = vr[i]; } }
}

struct AttnIn {
    const bf16_t* q;
    const bf16_t *K, *V;
    int kstride, vstride;
    int jlo, jhi;
    int t;
    int tw_lo, tw_hi;
    float sc;
    unsigned long long sel_lo, sel_hi;
    unsigned long long wsel_lo, wsel_hi;
    int tt;
};

template <int MODE> DI bool key_ok(int key, int t) {
    if (MODE == 0 || MODE == 3) return key <= t;
    if (MODE == 1) return key <= t && key >= t - 511;
    if (MODE == 2) return 16 * key + 31 <= t;
    return true;
}

template <int DK, int DV>
DI void tile_pv(LAS unsigned char* kb, const f32x16& S0, const f32x16& S1, f32x16 (&O)[DV / 32]) {
    using L = ALay<DK, DV>;
    const int lane = threadIdx.x & 63, h = lane >> 5, i16 = lane & 15, q4 = i16 >> 2, p4 = i16 & 3, g16 = lane >> 4;
    LAS unsigned char* vb_ = kb + L::KBYTES;
    __builtin_amdgcn_s_setprio(1);
#pragma unroll
    for (int kb2 = 0; kb2 < 2; ++kb2)
#pragma unroll
        for (int s2 = 0; s2 < 2; ++s2) {
            u32x4 pw;
            if (kb2 == 0) { pw.x = pk2(S0[8 * s2 + 0], S0[8 * s2 + 1]); pw.y = pk2(S0[8 * s2 + 2], S0[8 * s2 + 3]); pw.z = pk2(S0[8 * s2 + 4], S0[8 * s2 + 5]); pw.w = pk2(S0[8 * s2 + 6], S0[8 * s2 + 7]); }
            else          { pw.x = pk2(S1[8 * s2 + 0], S1[8 * s2 + 1]); pw.y = pk2(S1[8 * s2 + 2], S1[8 * s2 + 3]); pw.z = pk2(S1[8 * s2 + 4], S1[8 * s2 + 5]); pw.w = pk2(S1[8 * s2 + 6], S1[8 * s2 + 7]); }
            const bf16x8 pb = __builtin_bit_cast(bf16x8, pw);
            const int vrow = 32 * kb2 + 16 * s2 + 4 * h + q4;
#pragma unroll
            for (int d = 0; d < DV / 32; ++d) {
                const int vcol = d * 32 + 16 * (g16 & 1) + 4 * p4;
                const s16x4 lo = __builtin_amdgcn_ds_read_tr16_b64_v4i16((LAS s16x4*)(vb_ + vrow * L::VSB + vcol * 2));
                const s16x4 hi = __builtin_amdgcn_ds_read_tr16_b64_v4i16((LAS s16x4*)(vb_ + (vrow + 8) * L::VSB + vcol * 2));
                bf16x8 va; va[0] = lo[0]; va[1] = lo[1]; va[2] = lo[2]; va[3] = lo[3]; va[4] = hi[0]; va[5] = hi[1]; va[6] = hi[2]; va[7] = hi[3];
                O[d] = __builtin_amdgcn_mfma_f32_32x32x16_bf16(va, pb, O[d], 0, 0, 0);
            }
        }
    __builtin_amdgcn_s_setprio(0);
}

template <int DK, int DV>
DI void tile_qk(LAS unsigned char* kb, const bf16x8 (&qf)[DK / 16], f32x16& S0, f32x16& S1) {
    using L = ALay<DK, DV>;
    const int lane = threadIdx.x & 63, r = lane & 31, h = lane >> 5;
    const f32x16 z16 = {0.f, 0.f, 0.f, 0.f, 0.f, 0.f, 0.f, 0.f, 0.f, 0.f, 0.f, 0.f, 0.f, 0.f, 0.f, 0.f};
    __builtin_amdgcn_s_setprio(1);
#pragma unroll
    for (int s = 0; s < DK / 16; ++s) {
        const bf16x8 a0 = *(const LAS bf16x8*)(kb + r * L::KSB + (16 * s + 8 * h) * 2);
        const bf16x8 a1 = *(const LAS bf16x8*)(kb + (32 + r) * L::KSB + (16 * s + 8 * h) * 2);
        S0 = __builtin_amdgcn_mfma_f32_32x32x16_bf16(a0, qf[s], s == 0 ? z16 : S0, 0, 0, 0);
        S1 = __builtin_amdgcn_mfma_f32_32x32x16_bf16(a1, qf[s], s == 0 ? z16 : S1, 0, 0, 0);
    }
    __builtin_amdgcn_s_setprio(0);
}
template <int DK, int DV, int MODE, int PASS, bool FULL>
DI void tile_smpv(LAS unsigned char* lds, LAS unsigned char* kb, const AttnIn& in, int j, f32x16& S0, f32x16& S1, f32x16 (&O)[DV / 32], float& m, float& l, float inv_l) {
    const int lane = threadIdx.x & 63, h = lane >> 5;
    const int key0 = j * 64;
    const unsigned long long selw = (j < 64) ? in.sel_lo : in.sel_hi;
    const bool rowsel = (MODE == 3) ? ((selw >> (j & 63)) & 1ull) : true;
    if (FULL && PASS == 0) {
        float mx = fmaxf(S0[0], S1[0]);
#pragma unroll
        for (int i = 1; i < 16; ++i) mx = fmaxf(mx, fmaxf(S0[i], S1[i]));
        const float rb = (MODE == 3 && !rowsel) ? -1e30f : 0.f;
        mx = mx * in.sc + rb;
        mx = fmaxf(mx, __shfl_xor(mx, 32));
        if (__any(mx - m > 8.0f)) {
            const float mn = fmaxf(m, mx);
            const float alpha = ex2(m - mn);
            m = mn;
            l *= alpha;
#pragma unroll
            for (int d = 0; d < DV / 32; ++d) O[d] *= alpha;
        }
        const float off = rb - m;
        float ls = 0.f;
#pragma unroll
        for (int i = 0; i < 16; ++i) { const float p0 = ex2(__builtin_fmaf(S0[i], in.sc, off)), p1 = ex2(__builtin_fmaf(S1[i], in.sc, off)); S0[i] = p0; S1[i] = p1; ls += p0 + p1; }
        l += ls;
        tile_pv<DK, DV>(kb, S0, S1, O);
        return;
    }
    int thr = 63, lo = 0;
    if (MODE == 0 || MODE == 3) thr = in.t - key0 - 4 * h;
    if (MODE == 1) { thr = in.t - key0 - 4 * h; lo = thr - 511; }
    if (MODE == 2) thr = ((in.t - 31) >> 4) - key0 - 4 * h;
    if (MODE == 3 && !rowsel) thr = -1;
#define VOK(c) (FULL || (MODE == 4) || (((c) <= thr) && (MODE != 1 || (c) >= lo)))
    if (PASS != 2) {
        float mx = -1e30f;
#pragma unroll
        for (int i = 0; i < 16; ++i) { const int c = 8 * (i >> 2) + (i & 3); S0[i] *= in.sc; S1[i] *= in.sc;
            mx = fmaxf(mx, VOK(c) ? S0[i] : -1e30f); mx = fmaxf(mx, VOK(c + 32) ? S1[i] : -1e30f); }
        mx = fmaxf(mx, __shfl_xor(mx, 32));
        const float mn = fmaxf(m, mx);
        const float alpha = ex2(m - mn);
        m = mn;
        float ls = 0.f;
#pragma unroll
        for (int i = 0; i < 16; ++i) { const int c = 8 * (i >> 2) + (i & 3);
            const float p0 = VOK(c) ? ex2(S0[i] - mn) : 0.f; const float p1 = VOK(c + 32) ? ex2(S1[i] - mn) : 0.f;
            S0[i] = p0; S1[i] = p1; ls += p0 + p1; }
        l = l * alpha + ls;
        if (PASS == 0) {
#pragma unroll
            for (int d = 0; d < DV / 32; ++d) O[d] *= alpha;
        }
    } else {
#pragma unroll
        for (int i = 0; i < 16; ++i) { const int c = 8 * (i >> 2) + (i & 3);
            const float p0 = VOK(c) ? ex2(S0[i] * in.sc - m) * inv_l : 0.f; const float p1 = VOK(c + 32) ? ex2(S1[i] * in.sc - m) * inv_l : 0.f;
            S0[i] = p0; S1[i] = p1; }
#undef VOK
        LAS unsigned* imp = (LAS unsigned*)(lds + LDS_IMP) + in.tt * IMPS;
#pragma unroll
        for (int kb2 = 0; kb2 < 2; ++kb2)
#pragma unroll
            for (int g4 = 0; g4 < 4; ++g4) {
                const float e0 = kb2 ? S1[4 * g4] : S0[4 * g4], e1 = kb2 ? S1[4 * g4 + 1] : S0[4 * g4 + 1], e2 = kb2 ? S1[4 * g4 + 2] : S0[4 * g4 + 2], e3 = kb2 ? S1[4 * g4 + 3] : S0[4 * g4 + 3];
                const int js = (key0 >> 2) + 8 * kb2 + 2 * g4 + h;
                const unsigned wm = (unsigned)((e0 + e1 + e2 + 0.5f * e3) * 536870912.f + 0.5f);
                const unsigned wh = (unsigned)(0.5f * e3 * 536870912.f + 0.5f);
                if (wm != 0u) __hip_atomic_fetch_add(imp + js, wm, __ATOMIC_RELAXED, __HIP_MEMORY_SCOPE_WORKGROUP);
                if (wh != 0u && js + 1 < 128) __hip_atomic_fetch_add(imp + js + 1, wh, __ATOMIC_RELAXED, __HIP_MEMORY_SCOPE_WORKGROUP);
            }
    }
    if (PASS != 1) tile_pv<DK, DV>(kb, S0, S1, O);
}

DI void lds_barrier() { asm volatile("s_waitcnt lgkmcnt(0)" ::: "memory"); __builtin_amdgcn_s_barrier(); asm volatile("" ::: "memory"); }
template <int MODE> DI void tile_flags(const AttnIn& in, int j, bool& wave_on, bool& full) {
    const int key0 = j * 64;
    wave_on = true; full = false;
    if (MODE == 0 || MODE == 3) { wave_on = key0 <= in.tw_hi; full = key0 + 63 <= in.tw_lo; }
    if (MODE == 3) wave_on = wave_on && ((((j < 64) ? in.wsel_lo : in.wsel_hi) >> (j & 63)) & 1ull);
    if (MODE == 1) { wave_on = (key0 <= in.tw_hi) && (key0 + 63 >= in.tw_lo - 511); full = (key0 + 63 <= in.tw_lo) && (key0 >= in.tw_hi - 511); }
    if (MODE == 2) { wave_on = 16 * key0 + 31 <= in.tw_hi; full = 16 * (key0 + 63) + 31 <= in.tw_lo; }
    if (MODE == 4) full = true;
}
template <int DK, int DV, int MODE, int PASS>
DI void smpv_dispatch(LAS unsigned char* lds, LAS unsigned char* kb, const AttnIn& in, int j, f32x16& S0, f32x16& S1, f32x16 (&O)[DV / 32], float& m, float& l, float inv_l) {
    bool wave_on, full; tile_flags<MODE>(in, j, wave_on, full);
    if (!wave_on) return;
    if (PASS == 0 && full) tile_smpv<DK, DV, MODE, PASS, true>(lds, kb, in, j, S0, S1, O, m, l, inv_l);
    else tile_smpv<DK, DV, MODE, PASS, false>(lds, kb, in, j, S0, S1, O, m, l, inv_l);
}
template <int DK, int DV, int MODE, int PASS>
DI void attn_stream(LAS unsigned char* lds, const AttnIn& in, const bf16x8 (&qf)[DK / 16], f32x16 (&O)[DV / 32], float& m, float& l) {
    using L = ALay<DK, DV>;
    static_assert(2 * L::BUF <= LDS_IMP, "tile buffers");
    u32x4 kr[L::KI], vr[L::VI];
    int j = in.jlo;
    LAS const unsigned* uni = (LAS const unsigned*)(lds + LDS_UNI);
    auto tile_on = [&](int jj) -> bool { if (MODE == 3) return (uni[jj >> 5] >> (jj & 31)) & 1u; return true; };
    while (j <= in.jhi && !tile_on(j)) ++j;
    if (j > in.jhi) return;
    const float inv_l = (PASS == 2) ? 1.f / fmaxf(l, 1e-30f) : 0.f;
    tile_load<DK, DV>(in.K + (size_t)j * 64 * in.kstride, in.kstride, in.V + (size_t)j * 64 * in.vstride, in.vstride, kr, vr);
    tile_store<DK, DV>(lds, kr, vr);
    __syncthreads();
    int cur = 0;
    f32x16 S0, S1;
    for (;;) {
        int jn = j + 1;
        while (jn <= in.jhi && !tile_on(jn)) ++jn;
        const bool has_next = jn <= in.jhi;
        if (has_next) tile_load<DK, DV>(in.K + (size_t)jn * 64 * in.kstride, in.kstride, in.V + (size_t)jn * 64 * in.vstride, in.vstride, kr, vr);
        LAS unsigned char* kb = lds + cur * L::BUF;
        bool wave_on, full; tile_flags<MODE>(in, j, wave_on, full);
        if (wave_on) {
            tile_qk<DK, DV>(kb, qf, S0, S1);
            if ((PASS == 0 || MODE == 2) && full) tile_smpv<DK, DV, MODE, PASS, true>(lds, kb, in, j, S0, S1, O, m, l, inv_l);
            else tile_smpv<DK, DV, MODE, PASS, false>(lds, kb, in, j, S0, S1, O, m, l, inv_l);
        }
        if (has_next) tile_store<DK, DV>(lds + (cur ^ 1) * L::BUF, kr, vr);
        lds_barrier();
        if (!has_next) break;
        j = jn; cur ^= 1;
    }
}

template <int DK> DI void load_q(const bf16_t* q, bf16x8 (&qf)[DK / 16]) {
    const int h = (threadIdx.x & 63) >> 5;
#pragma unroll
    for (int s = 0; s < DK / 16; ++s) qf[s] = *(const bf16x8*)(q + 16 * s + 8 * h);
}
template <int NV> DI void zeroO(f32x16 (&O)[NV]) {
#pragma unroll
    for (int d = 0; d < NV; ++d)
#pragma unroll
        for (int i = 0; i < 16; ++i) O[d][i] = 0.f;
}

template <int DK, int DV, int MODE>
DI void attn_mha_item(LAS unsigned char* lds, const bf16_t* Q, int qstride, const bf16_t* K, int kstride, const bf16_t* V, int vstride, bf16_t* Out, int ostride, int t0, int jhi, float sc) {
    const int wid = threadIdx.x >> 6, lane = threadIdx.x & 63, r = lane & 31, h = lane >> 5;
    AttnIn in; in.t = t0 + 32 * wid + r; in.tw_lo = t0 + 32 * wid; in.tw_hi = in.tw_lo + 31;
    in.q = Q + (size_t)in.t * qstride; in.K = K; in.V = V; in.kstride = kstride; in.vstride = vstride; in.jlo = 0; in.jhi = jhi; in.sc = sc;
    in.sel_lo = in.sel_hi = 0ull; in.wsel_lo = in.wsel_hi = ~0ull; in.tt = 0;
    bf16x8 qf[DK / 16]; load_q<DK>(in.q, qf);
    f32x16 O[DV / 32]; zeroO(O);
    float m = -1e30f, l = 0.f;
    attn_stream<DK, DV, MODE, 0>(lds, in, qf, O, m, l);
    l += __shfl_xor(l, 32);
    const float inv = 1.f / fmaxf(l, 1e-30f);
    bf16_t* o = Out + (size_t)in.t * ostride;
#pragma unroll
    for (int d = 0; d < DV / 32; ++d)
#pragma unroll
        for (int g4 = 0; g4 < 4; ++g4) { u32x2 w; w.x = pk2(O[d][4 * g4] * inv, O[d][4 * g4 + 1] * inv); w.y = pk2(O[d][4 * g4 + 2] * inv, O[d][4 * g4 + 3] * inv);
            *(u32x2*)(o + d * 32 + 8 * g4 + 4 * h) = w; }
}

template <int BR>
DI void nsa_item(LAS unsigned char* lds, const Params& p, int b, int g, int qt) {
    unsigned char* ws = p.ws;
    const int wid = threadIdx.x >> 6, lane = threadIdx.x & 63, r = lane & 31, h = lane >> 5;
    const int head = (BR == 3) ? 4 * g + (r >> 3) : 4 * g + (wid >> 1), t0 = qt * 64;
    AttnIn in;
    if (BR == 3) { in.tt = 8 * wid + (r & 7); in.tw_lo = t0 + 8 * wid; in.tw_hi = in.tw_lo + 7; }
    else { in.tt = 32 * (wid & 1) + r; in.tw_lo = t0 + 32 * (wid & 1); in.tw_hi = in.tw_lo + 31; }
    in.t = t0 + in.tt; in.wsel_lo = in.wsel_hi = ~0ull;
    const size_t tok = (size_t)b * SEQ + in.t;
    in.q = (const bf16_t*)(ws + O_QA) + (tok * 16 + head) * 96;
    in.sc = 0.10206207261596577f * 1.4426950408889634f;
    in.sel_lo = in.sel_hi = 0ull;
    const float* gnp = (const float*)(ws + O_GN) + tok * 48 + head * 3;
    bf16_t* oacc = (bf16_t*)(ws + O_OACC) + tok * 1024 + head * 64;
    bf16x8 qf[6]; load_q<96>(in.q, qf);
    f32x16 O[2]; zeroO(O);
    float m = -1e30f, l = 0.f;
    if (BR == 1) {
        in.K = (const bf16_t*)(ws + O_KW) + ((size_t)b * SEQ * 4 + g) * 96; in.kstride = 384;
        in.V = (const bf16_t*)(ws + O_VW) + ((size_t)b * SEQ * 4 + g) * 64; in.vstride = 256;
        in.jlo = qt >= 8 ? qt - 8 : 0; in.jhi = qt;
        attn_stream<96, 64, 1, 0>(lds, in, qf, O, m, l);
        l += __shfl_xor(l, 32);
        const float sc = gnp[2] / fmaxf(l, 1e-30f);
#pragma unroll
        for (int d = 0; d < 2; ++d)
#pragma unroll
            for (int g4 = 0; g4 < 4; ++g4) { u32x2 w; w.x = pk2(O[d][4 * g4] * sc, O[d][4 * g4 + 1] * sc); w.y = pk2(O[d][4 * g4 + 2] * sc, O[d][4 * g4 + 3] * sc); *(u32x2*)(oacc + d * 32 + 8 * g4 + 4 * h) = w; }
    }
    if (BR == 2) {
#ifdef DBG_KW
        in.K = (const bf16_t*)(ws + O_KCC) + ((size_t)b * 512 * 4 + g) * 96; in.kstride = 384;
        in.V = (const bf16_t*)(ws + O_VW) + ((size_t)b * SEQ * 4 + g) * 64; in.vstride = 256;
#else
        in.K = (const bf16_t*)(ws + O_KCC) + ((size_t)b * 512 * 4 + g) * 96; in.kstride = 384;
        in.V = (const bf16_t*)(ws + O_VCC) + ((size_t)b * 512 * 4 + g) * 64; in.vstride = 256;
#endif
        in.jlo = 0; in.jhi = ((t0 + 32) >> 4) >> 6;
        LAS unsigned* imp = (LAS unsigned*)(lds + LDS_IMP);
        for (int i = threadIdx.x; i < 64 * IMPS; i += NTHREADS) imp[i] = 0u;
        attn_stream<96, 64, 2, 1>(lds, in, qf, O, m, l);
        l += __shfl_xor(l, 32);
        zeroO(O);
        attn_stream<96, 64, 2, 2>(lds, in, qf, O, m, l);
        const float sc = gnp[0];
#pragma unroll
        for (int d = 0; d < 2; ++d)
#pragma unroll
            for (int g4 = 0; g4 < 4; ++g4) { u32x2* dp = (u32x2*)(oacc + d * 32 + 8 * g4 + 4 * h); const u32x2 hw = *dp;
                u32x2 w; w.x = pk2(bf2f(hw.x & 0xffffu) + O[d][4 * g4] * sc, bf2f(hw.x >> 16) + O[d][4 * g4 + 1] * sc); w.y = pk2(bf2f(hw.y & 0xffffu) + O[d][4 * g4 + 2] * sc, bf2f(hw.y >> 16) + O[d][4 * g4 + 3] * sc); *dp = w; }
#ifndef DBG_NO_IMP
        const int cur = qt;
        u32x4* selp = (u32x4*)(ws + O_SEL);
#pragma unroll 1
        for (int rr = 0; rr < 8; ++rr) {
            const int tt = wid * 8 + rr;
            LAS const unsigned* row = imp + tt * IMPS;
            unsigned long long blo, bhi;
            if (cur < 16) { blo = __ballot(lane <= cur); bhi = 0ull; }
            else {
                const int ja = lane, jb = lane + 64;
                const bool fa = (ja == 0) || (ja == cur) || (ja == cur - 1), fb = (jb == cur) || (jb == cur - 1);
                const unsigned xa = (ja <= cur) ? (fa ? 0xffffffffu : row[ja] + 1u) : 0u, xb = (jb <= cur) ? (fb ? 0xffffffffu : row[jb] + 1u) : 0u;
                unsigned Tk = 0u;
#pragma unroll 1
                for (int bit = 31; bit >= 0; --bit) { const unsigned c = Tk | (1u << bit);
                    const int cnt = __popcll(__ballot(xa >= c)) + __popcll(__ballot(xb >= c)); if (cnt >= 16) Tk = c; }
                const int ngt = __popcll(__ballot(xa > Tk)) + __popcll(__ballot(xb > Tk));
                const int need = 16 - ngt;
                const unsigned long long ta = __ballot(xa == Tk), tb = __ballot(xb == Tk), lt = (1ull << lane) - 1ull;
                const int pa = __popcll(ta & lt), pb = __popcll(ta) + __popcll(tb & lt);
                blo = __ballot(xa > Tk || (xa == Tk && pa < need)); bhi = __ballot(xb > Tk || (xb == Tk && pb < need));
            }
            if (lane == 0) { u32x4 w; w.x = (unsigned)blo; w.y = (unsigned)(blo >> 32); w.z = (unsigned)bhi; w.w = (unsigned)(bhi >> 32);
                selp[((size_t)b * SEQ + t0 + tt) * 4 + g] = w; }
        }
#endif
        __syncthreads();
    }
    if (BR == 3) {
        in.K = (const bf16_t*)(ws + O_KS) + ((size_t)b * SEQ * 4 + g) * 96; in.kstride = 384;
        in.V = (const bf16_t*)(ws + O_VS) + ((size_t)b * SEQ * 4 + g) * 64; in.vstride = 256;
        in.jlo = 0; in.jhi = qt;
        const u32x4 sw = ((const u32x4*)(ws + O_SEL))[tok * 4 + g];
        in.sel_lo = (unsigned long long)sw.x | ((unsigned long long)sw.y << 32); in.sel_hi = (unsigned long long)sw.z | ((unsigned long long)sw.w << 32);
        LAS unsigned* uni = (LAS unsigned*)(lds + LDS_UNI);
        if (threadIdx.x < 4) uni[threadIdx.x] = 0u;
        __syncthreads();
        { unsigned long long wl = in.sel_lo, wh = in.sel_hi;
#pragma unroll
          for (int o = 1; o < 8; o <<= 1) { wl |= __shfl_xor(wl, o); wh |= __shfl_xor(wh, o); }
          in.wsel_lo = __builtin_amdgcn_readfirstlane((unsigned)wl) | ((unsigned long long)__builtin_amdgcn_readfirstlane((unsigned)(wl >> 32)) << 32);
          in.wsel_hi = __builtin_amdgcn_readfirstlane((unsigned)wh) | ((unsigned long long)__builtin_amdgcn_readfirstlane((unsigned)(wh >> 32)) << 32); }
        if ((r >> 3) == 0) {
            __hip_atomic_fetch_or(uni + 0, sw.x, __ATOMIC_RELAXED, __HIP_MEMORY_SCOPE_WORKGROUP); __hip_atomic_fetch_or(uni + 1, sw.y, __ATOMIC_RELAXED, __HIP_MEMORY_SCOPE_WORKGROUP);
            __hip_atomic_fetch_or(uni + 2, sw.z, __ATOMIC_RELAXED, __HIP_MEMORY_SCOPE_WORKGROUP); __hip_atomic_fetch_or(uni + 3, sw.w, __ATOMIC_RELAXED, __HIP_MEMORY_SCOPE_WORKGROUP);
        }
        __syncthreads();
#ifndef DBG_SEL_SKIP
        attn_stream<96, 64, 3, 0>(lds, in, qf, O, m, l);
#endif
        l += __shfl_xor(l, 32);
        const float sc = gnp[1] / fmaxf(l, 1e-30f);
        bf16_t* oa = (bf16_t*)(ws + O_OA) + tok * 1024 + head * 64;
#pragma unroll
        for (int d = 0; d < 2; ++d)
#pragma unroll
            for (int g4 = 0; g4 < 4; ++g4) { const u32x2 hw = *(const u32x2*)(oacc + d * 32 + 8 * g4 + 4 * h);
                u32x2 w; w.x = pk2(bf2f(hw.x & 0xffffu) + O[d][4 * g4] * sc, bf2f(hw.x >> 16) + O[d][4 * g4 + 1] * sc); w.y = pk2(bf2f(hw.y & 0xffffu) + O[d][4 * g4 + 2] * sc, bf2f(hw.y >> 16) + O[d][4 * g4 + 3] * sc);
                *(u32x2*)(oa + d * 32 + 8 * g4 + 4 * h) = w; }
    }
}

DI int snake_rank(int i) { const int G = gridDim.x, b = blockIdx.x; return i * G + ((i & 1) ? (G - 1 - b) : b); }


#define XB_TMO      128
#define XB_XCNT(j)  (256  + 64 * (j))
#define XB_XSUB(j)  (1280 + 64 * (j))
#define XB_XGEN(j)  (2304 + 64 * (j))
#define XB_TOP      3328
#define XB_TOPGEN   3392
#define XB_SPIN_CAP (1u << 18)
DI unsigned xb_ld(unsigned* p)              { return __hip_atomic_load(p, __ATOMIC_RELAXED, __HIP_MEMORY_SCOPE_AGENT); }
DI unsigned xb_add(unsigned* p, unsigned v) { return __hip_atomic_fetch_add(p, v, __ATOMIC_RELAXED, __HIP_MEMORY_SCOPE_AGENT); }
DI unsigned xb_xcc_id() { return (unsigned)__builtin_amdgcn_s_getreg((3 << 11) | 20) & 0xFu; }
#define XB_SPIN(cond, bar) do { unsigned _sp = 0; while (cond) { __builtin_amdgcn_s_sleep(1); \
    if ((++_sp & 255u) == 0u) { if (xb_ld(&(bar)[XB_TMO])) break; if (_sp > XB_SPIN_CAP) { atomicAdd(&(bar)[XB_TMO], 1u); break; } } } } while (0)
struct XcdBarrier { unsigned* bar; unsigned x; volatile LAS unsigned* st; };
DI XcdBarrier xcd_barrier_post(unsigned* bar, volatile LAS unsigned* st) {
    XcdBarrier b; b.bar = bar; b.x = xb_xcc_id(); b.st = st;
    if (threadIdx.x == 0) (void)xb_add(&bar[XB_XCNT(b.x)], 1u);
    return b;
}
DI void xcd_barrier_complete(unsigned* bar, unsigned x, unsigned& nloc, unsigned& nx) {
    const unsigned G = gridDim.x * gridDim.y * gridDim.z;
    unsigned sum, cnt, mine, sp = 0u;
    for (;;) {
        sum = 0u; cnt = 0u; mine = 0u;
#pragma unroll
        for (unsigned j = 0; j < 16; ++j) { const unsigned c = xb_ld(&bar[XB_XCNT(j)]); sum += c; cnt += (c > 0u) ? 1u : 0u; mine = (j == x) ? c : mine; }
        if (sum == G) break;
        __builtin_amdgcn_s_sleep(1);
        if ((++sp & 255u) == 0u) { if (xb_ld(&bar[XB_TMO])) break; if (sp > XB_SPIN_CAP) { atomicAdd(&bar[XB_TMO], 1u); break; } }
    }
    nloc = mine > 0u ? mine : 1u; nx = cnt > 0u ? cnt : 1u;
}
DI void xcd_barrier(const XcdBarrier& b) {
    asm volatile("s_waitcnt vmcnt(0)" ::: "memory");
    __syncthreads();
    if (threadIdx.x == 0) {
        unsigned* bar = b.bar;
        __builtin_amdgcn_s_waitcnt(0);
        unsigned nloc = b.st[0], nx = b.st[1];
        if (nloc == 0u) { xcd_barrier_complete(bar, b.x, nloc, nx); b.st[0] = nloc; b.st[1] = nx; }
        const unsigned old = xb_add(&bar[XB_XSUB(b.x)], 1u);
        const unsigned gen = old / nloc;
        if (old + 1u == (gen + 1u) * nloc) {
            __builtin_amdgcn_fence(__ATOMIC_RELEASE, "agent");
            asm volatile("s_waitcnt vmcnt(0)" ::: "memory");
            const unsigned og = xb_add(&bar[XB_TOP], 1u);
            const unsigned tg = og / nx;
            if (og + 1u == (tg + 1u) * nx) xb_add(&bar[XB_TOPGEN], 1u);
            else XB_SPIN(xb_ld(&bar[XB_TOPGEN]) == tg, bar);
            __builtin_amdgcn_fence(__ATOMIC_ACQUIRE, "agent");
            xb_add(&bar[XB_XGEN(b.x)], 1u);
            asm volatile("s_waitcnt vmcnt(0)" ::: "memory");
        } else {
            XB_SPIN(xb_ld(&bar[XB_XGEN(b.x)]) == gen, bar);
            __builtin_amdgcn_fence(__ATOMIC_ACQUIRE, "agent");
            asm volatile("s_waitcnt vmcnt(0)" ::: "memory");
        }
    }
    __syncthreads();
}

#ifndef PHMASK
#define PHMASK 0xFFFF
#endif
#define PHON(n) ((PHMASK >> (n)) & 1)
__global__ void __launch_bounds__(NTHREADS, 2) fwd_megakernel(Params p_arg) {
    const Params& p = *(const Params*)__builtin_amdgcn_kernarg_segment_ptr();
    extern __shared__ __attribute__((aligned(16))) unsigned char smem[];
    LAS unsigned char* lds = (LAS unsigned char*)smem;
    cg::grid_group grid = cg::this_grid();
    __shared__ uint4 xb_words;
    if (threadIdx.x == 0) xb_words = make_uint4(0u, 0u, 0u, 0u);
    __syncthreads();
    const XcdBarrier xb = xcd_barrier_post((unsigned*)(p_arg.ws + O_BAR), (volatile LAS unsigned*)&xb_words);
    unsigned char* ws = p.ws;
    const int gwave = blockIdx.x * (NTHREADS / 64) + (threadIdx.x >> 6), nwave = gridDim.x * (NTHREADS / 64);
    float* ssq = (float*)(ws + O_SSQ);
    if (PHON(0) && p.ph_lo <= 0 && 0 < p.ph_hi) { phase_prep(p, lds); }
    if (PHON(1) && p.ph_lo <= 1 && 1 < p.ph_hi) { if (1 > p.ph_lo) grid.sync();
            FGemm1 f{ws, 256};
            run_gemm(lds, (const bf16_t*)(ws + O_XN), (const bf16_t*)(ws + O_WIN) + (size_t)256 * 2048, T, 4096, 2048, f, 0);
            FMemKV fm{(bf16_t*)(ws + O_KMEM), (bf16_t*)(ws + O_VMEM)};
            run_gemm(lds, (const bf16_t*)(ws + O_MEMN), (const bf16_t*)(ws + O_WXKV), BATCH * MEM, 1024, 2048, fm, 128);
    }
    if (PHON(2) && p.ph_lo <= 2 && 2 < p.ph_hi) { if (2 > p.ph_lo) xcd_barrier(xb);
#ifndef P2SEL
#define P2SEL 7
#endif
            { FGemm1 f0{ws, 0}; run_gemm(lds, (const bf16_t*)(ws + O_XN), (const bf16_t*)(ws + O_WIN), T, 256, 2048, f0, 128); }
            if (P2SEL & 1) { FUq fq{ws}; run_gemm(lds, (const bf16_t*)(ws + O_CQ), (const bf16_t*)(ws + O_WUQ), T, 1536, 512, fq, 0); }
            if (P2SEL & 2) { FUkv fk{ws}; run_gemm(lds, (const bf16_t*)(ws + O_CKV), (const bf16_t*)(ws + O_WUK), T, 2048, 256, fk, 0); }
#ifndef NO_CMP1
            for (int wt = gwave; wt < 1024; wt += nwave) {
                if (wt < 512) compress_stage1<96>((const bf16_t*)(ws + O_KC), (const bf16_t*)(ws + O_W1K), (const float*)(ws + O_BIASK), (bf16_t*)(ws + O_HK), wt);
                else compress_stage1<64>((const bf16_t*)(ws + O_VC), (const bf16_t*)(ws + O_W1V), (const float*)(ws + O_BIASK) + 96, (bf16_t*)(ws + O_HV), wt - 512);
            }
#endif
    }
    if (PHON(3) && p.ph_lo <= 3 && 3 < p.ph_hi) { if (3 > p.ph_lo) xcd_barrier(xb);
            for (int wt = gwave; wt < 1024; wt += nwave) {
                if (wt < 512) compress_stage2<96>((const bf16_t*)(ws + O_HK), (const bf16_t*)(ws + O_W2K), (bf16_t*)(ws + O_KCC), wt);
                else compress_stage2<64>((const bf16_t*)(ws + O_HV), (const bf16_t*)(ws + O_W2V), (bf16_t*)(ws + O_VCC), wt - 512);
            }
            for (int i = 0;; ++i) { const int rk = snake_rank(i); if (rk >= 2048) break;
                const int qt = 31 - (rk >> 6), bh = rk & 63, b = bh >> 4, hd = bh & 15;
                attn_mha_item<96, 64, 0>(lds, (const bf16_t*)(ws + O_QMLA) + ((size_t)b * SEQ * 16 + hd) * 96, 1536, (const bf16_t*)(ws + O_KMLA) + ((size_t)b * SEQ * 16 + hd) * 96, 1536,
                                         (const bf16_t*)(ws + O_VMLA) + ((size_t)b * SEQ * 16 + hd) * 64, 1024, (bf16_t*)(ws + O_OB) + (size_t)b * SEQ * 1024 + hd * 64, 1024, qt * 256, qt * 4 + 3,
                                         0.10206207261596577f * 1.4426950408889634f); }
#ifndef DBG_NO_NSA
            for (int it = blockIdx.x; it < 2048; it += gridDim.x) { const int qt = it >> 4, bg = it & 15; nsa_item<1>(lds, p, bg >> 2, bg & 3, qt); }
#endif
    }
#ifdef DBG_PROBE
    { grid.sync();
      if (blockIdx.x == 0) {
          unsigned code = 0;
          const bf16_t* bufs[5] = {(const bf16_t*)(ws + O_KC), (const bf16_t*)(ws + O_W1K), (const bf16_t*)(ws + O_HK), (const bf16_t*)(ws + O_W2K), (const bf16_t*)(ws + O_KCC)};
          const int lens[5] = {4 * 1024 * 1024, 96 * 3072, 8192 * 96, 96 * 96, 8192 * 96};
          const int bits[5] = {1, 2, 8, 16, 32};
          LAS unsigned* red = (LAS unsigned*)lds;
          if (threadIdx.x == 0) red[0] = 0u;
          __syncthreads();
          for (int q = 0; q < 5; ++q) { unsigned bad = 0; for (int i = threadIdx.x; i < lens[q]; i += NTHREADS) { if ((bufs[q][i] & 0x7f80u) == 0x7f80u) bad = 1; }
              if (bad) __hip_atomic_fetch_or(red, (unsigned)bits[q], __ATOMIC_RELAXED, __HIP_MEMORY_SCOPE_WORKGROUP); }
          if (threadIdx.x < 160) { const unsigned u = __float_as_uint(((const float*)(ws + O_BIASK))[threadIdx.x]); if ((u & 0x7f800000u) == 0x7f800000u) __hip_atomic_fetch_or(red, 4u, __ATOMIC_RELAXED, __HIP_MEMORY_SCOPE_WORKGROUP); }
          __syncthreads();
          if (threadIdx.x == 0) ((float*)(ws + O_BIASK))[200] = (float)((10 + red[0]) * 100);
          __syncthreads();
      }
    }
#endif
    if (PHON(4) && p.ph_lo <= 4 && 4 < p.ph_hi) { if (4 > p.ph_lo) xcd_barrier(xb);
            for (int i = 0;; ++i) { const int rk = snake_rank(i); if (rk >= 2048) break; const int qt = 127 - (rk >> 4), bg = rk & 15; nsa_item<2>(lds, p, bg >> 2, bg & 3, qt); }
    }
    if (PHON(5) && p.ph_lo <= 5 && 5 < p.ph_hi) { if (5 > p.ph_lo) xcd_barrier(xb);
#ifndef NO_SEL
            for (int i = 0;; ++i) { const int rk = snake_rank(i); if (rk >= 2048) break; const int qt = 127 - (rk >> 4), bg = rk & 15; nsa_item<3>(lds, p, bg >> 2, bg & 3, qt); }
#endif
#ifndef NO_GATE
            FGate fg{(bf16_t*)(ws + O_GATES)};
            run_gemm(lds, (const bf16_t*)(ws + O_XN), (const bf16_t*)(ws + O_WG), T, 4096, 2048, fg, 0);
#endif
    }
    if (PHON(6) && p.ph_lo <= 6 && 6 < p.ph_hi) { if (6 > p.ph_lo) xcd_barrier(xb);
#ifndef DBG_NO_NSA
            FMix<0> fa{(const bf16_t*)(ws + O_GATES), (bf16_t*)(ws + O_MIXED)};
            run_gemm(lds, (const bf16_t*)(ws + O_OA), (const bf16_t*)(ws + O_WONA), T, 2048, 1024, fa, 0);
#endif
            FMix<1> fb{(const bf16_t*)(ws + O_GATES), (bf16_t*)(ws + O_MIXED)};
            run_gemm(lds, (const bf16_t*)(ws + O_OB), (const bf16_t*)(ws + O_WONB), T, 2048, 1024, fb, 0);
    }
    if (PHON(7) && p.ph_lo <= 7 && 7 < p.ph_hi) { if (7 > p.ph_lo) xcd_barrier(xb);
            FResid<0> f{p.x, p.out, (bf16_t*)(ws + O_XN), ssq + 2 * T};
            run_gemm(lds, (const bf16_t*)(ws + O_MIXED), (const bf16_t*)(ws + O_WOUT), T, 2048, 2048, f, 0);
    }
#if defined(DBG_COPY) && DBG_COPY == 2
    { grid.sync();
      const int lane = threadIdx.x & 63;
      for (int row = gwave; row < T; row += nwave) {
          float ss = 0.f;
#pragma unroll
          for (int i = 0; i < 8; ++i) { const size_t o = (size_t)row * 2048 + (i * 64 + lane) * 4; const f32x4 v = *(const f32x4*)(p.x + o); *(f32x4*)(p.out + o) = v;
              u32x2 w; w.x = pk2(v[0], v[1]); w.y = pk2(v[2], v[3]); *(u32x2*)((bf16_t*)(ws + O_XN) + o) = w; ss += v[0]*v[0] + v[1]*v[1] + v[2]*v[2] + v[3]*v[3]; }
          ss = wave_sum(ss);
          if (lane == 0) ssq[DBG_COPY * T + row] = ss;
      }
    }
#endif
    if (PHON(8) && p.ph_lo <= 8 && 8 < p.ph_hi) { if (8 > p.ph_lo) xcd_barrier(xb);
            FXq f{(bf16_t*)(ws + O_QX), ssq + 2 * T};
            run_gemm(lds, (const bf16_t*)(ws + O_XN), (const bf16_t*)(ws + O_WXQ), T, 512, 2048, f, 0);
    }
    if (PHON(9) && p.ph_lo <= 9 && 9 < p.ph_hi) { if (9 > p.ph_lo) xcd_barrier(xb);
            for (int it = blockIdx.x; it < 512; it += gridDim.x) { const int qt = it >> 4, bh = it & 15, b = bh >> 2, hd = bh & 3;
                attn_mha_item<128, 128, 4>(lds, (const bf16_t*)(ws + O_QX) + ((size_t)b * SEQ * 4 + hd) * 128, 512, (const bf16_t*)(ws + O_KMEM) + ((size_t)b * MEM * 4 + hd) * 128, 512,
                                           (const bf16_t*)(ws + O_VMEM) + ((size_t)b * MEM * 4 + hd) * 128, 512, (bf16_t*)(ws + O_OX) + (size_t)b * SEQ * 512 + hd * 128, 512, qt * 256, 3,
                                           0.08838834764831845f * 1.4426950408889634f); }
    }
    if (PHON(10) && p.ph_lo <= 10 && 10 < p.ph_hi) { if (10 > p.ph_lo) xcd_barrier(xb);
            FResid<1> f{nullptr, p.out, (bf16_t*)(ws + O_XN), ssq + 3 * T};
            run_gemm(lds, (const bf16_t*)(ws + O_OX), (const bf16_t*)(ws + O_WXO), T, 2048, 512, f, 0);
    }
#if defined(DBG_COPY) && DBG_COPY == 3
    { grid.sync();
      const int lane = threadIdx.x & 63;
      for (int row = gwave; row < T; row += nwave) {
          float ss = 0.f;
#pragma unroll
          for (int i = 0; i < 8; ++i) { const size_t o = (size_t)row * 2048 + (i * 64 + lane) * 4; const f32x4 v = *(const f32x4*)(p.x + o); *(f32x4*)(p.out + o) = v;
              u32x2 w; w.x = pk2(v[0], v[1]); w.y = pk2(v[2], v[3]); *(u32x2*)((bf16_t*)(ws + O_XN) + o) = w; ss += v[0]*v[0] + v[1]*v[1] + v[2]*v[2] + v[3]*v[3]; }
          ss = wave_sum(ss);
          if (lane == 0) ssq[DBG_COPY * T + row] = ss;
      }
    }
#endif
    if (PHON(11) && p.ph_lo <= 11 && 11 < p.ph_hi) { if (11 > p.ph_lo) xcd_barrier(xb);
            FFf1 f{(bf16_t*)(ws + O_U), ssq + 3 * T};
            run_gemm(lds, (const bf16_t*)(ws + O_XN), (const bf16_t*)(ws + O_WFF1), T, 8192, 2048, f, 0);
    }
    if (PHON(12) && p.ph_lo <= 12 && 12 < p.ph_hi) { if (12 > p.ph_lo) xcd_barrier(xb);
            FResid<1> f{nullptr, p.out, (bf16_t*)(ws + O_XN), ssq + 4 * T};
            run_gemm(lds, (const bf16_t*)(ws + O_U), (const bf16_t*)(ws + O_WFF2), T, 2048, 8192, f, 0);
    }
    if (PHON(13) && p.ph_lo <= 13 && 13 < p.ph_hi) { if (13 > p.ph_lo) xcd_barrier(xb);
            const int lane = threadIdx.x & 63;
            for (int row = gwave; row < T; row += nwave) {
                const float rs = rsqrtf(ssq[4 * T + row] * (1.f / 2048.f) + EPS);
#pragma unroll
                for (int i = 0; i < 8; ++i) { float* op = p.out + (size_t)row * 2048 + (i * 64 + lane) * 4; const u32x2 hw = *(const u32x2*)((const bf16_t*)(ws + O_XN) + (size_t)row * 2048 + (i * 64 + lane) * 4);
                    const f32x4 v = (f32x4){bf2f(hw.x & 0xffffu), bf2f(hw.x >> 16), bf2f(hw.y & 0xffffu), bf2f(hw.y >> 16)}; const f32x4 gv = *(const f32x4*)(p.g_final + (i * 64 + lane) * 4);
                    *(f32x4*)op = (f32x4){v[0] * rs * gv[0], v[1] * rs * gv[1], v[2] * rs * gv[2], v[3] * rs * gv[3]}; }
            }
#ifdef DBG_PROBE
            grid.sync(); if (blockIdx.x == 0 && threadIdx.x == 0) p.out[0] = ((const float*)(ws + O_BIASK))[200];
#endif
    }
}

constexpr int NPHASES = 14;
#ifndef MK_MULTI
#define MK_MULTI 0
#endif

extern "C" void kernel_launch(void* const* d_in, const int* in_sizes, int n_in, void* d_out, int out_size, void* d_ws, size_t ws_size, hipStream_t stream) {
    static int grid = 0;
    if (grid == 0) {
        if (n_in != 27 || ws_size < O_END2) { fprintf(stderr, "kernel_launch: unexpected n_in %d / ws %zu (need %zu)\n", n_in, ws_size, (size_t)O_END2); grid = -1; return; }
        int dev = 0, cus = 0, per_cu = 0;
        hipGetDevice(&dev);
        hipDeviceGetAttribute(&cus, hipDeviceAttributeMultiprocessorCount, dev);
        if (hipFuncSetAttribute((const void*)fwd_megakernel, hipFuncAttributeMaxDynamicSharedMemorySize, LDS_BYTES) != hipSuccess) { fprintf(stderr, "kernel_launch: hipFuncSetAttribute failed\n"); grid = -1; return; }
        if (hipOccupancyMaxActiveBlocksPerMultiprocessor(&per_cu, (const void*)fwd_megakernel, NTHREADS, LDS_BYTES) != hipSuccess || per_cu < 1) { fprintf(stderr, "kernel_launch: occupancy query gave %d\n", per_cu); per_cu = 1; }
        (void)hipGetLastError();
        grid = cus * per_cu;
    }
    if (grid < 0) return;
    Params p{};
    const float** pp = (const float**)&p;
    for (int i = 0; i < 27; ++i) pp[i] = (const float*)d_in[i];
    p.out = (float*)d_out; p.ws = (unsigned char*)d_ws;
#if MK_MULTI
    for (int ph = 0; ph < NPHASES; ++ph) {
        p.ph_lo = ph; p.ph_hi = ph + 1;
        hipLaunchKernelGGL(fwd_megakernel, dim3(grid), dim3(NTHREADS), LDS_BYTES, stream, p);
    }
#else
    (void)hipMemsetAsync((char*)d_ws + O_BAR, 0, (size_t)XCD_BAR_WORDS * 4, stream);
    p.ph_lo = 0; p.ph_hi = NPHASES;
    void* args[] = {&p};
    hipError_t e = hipLaunchCooperativeKernel((const void*)fwd_megakernel, dim3(grid), dim3(NTHREADS), args, LDS_BYTES, stream);
    if (e != hipSuccess) fprintf(stderr, "cooperative launch failed: %s (grid %d)\n", hipGetErrorString(e), grid);
#endif
}
```

```cpp
#include <hip/hip_runtime.h>
#include <hip/hip_cooperative_groups.h>
#include <cstdio>
namespace cg = cooperative_groups;

#define LAS __attribute__((address_space(3)))
#define DI __device__ __forceinline__
typedef unsigned short bf16_t;
typedef short bf16x8 __attribute__((ext_vector_type(8)));
typedef short s16x4 __attribute__((ext_vector_type(4)));
typedef float f32x4 __attribute__((ext_vector_type(4)));
typedef float f32x16 __attribute__((ext_vector_type(16)));
typedef unsigned u32x4 __attribute__((ext_vector_type(4)));
typedef unsigned u32x2 __attribute__((ext_vector_type(2)));

constexpr int SEQ = 8192, BATCH = 4, T = BATCH * SEQ, DM = 2048, DFF = 8192, MEM = 256;
constexpr int DIN = 8400;
constexpr float EPS = 1e-6f;
constexpr int NTHREADS = 512;
constexpr int LDS_BYTES = 131072;

constexpr size_t al256(size_t x) { return (x + 255) & ~(size_t)255; }
constexpr size_t O_WIN = 0;
constexpr size_t O_WG = O_WIN + (size_t)4352 * 2048 * 2;
constexpr size_t O_WUQ = O_WG + (size_t)4096 * 2048 * 2;
constexpr size_t O_WUK = O_WUQ + (size_t)1536 * 512 * 2;
constexpr size_t O_WUV = O_WUK + (size_t)1024 * 256 * 2;
constexpr size_t O_W1K = O_WUV + (size_t)1024 * 256 * 2;
constexpr size_t O_W1V = O_W1K + (size_t)96 * 3072 * 2;
constexpr size_t O_W2K = O_W1V + (size_t)64 * 2048 * 2;
constexpr size_t O_W2V = al256(O_W2K + 96 * 96 * 2);
constexpr size_t O_WONA = al256(O_W2V + 64 * 64 * 2);
constexpr size_t O_WONB = O_WONA + (size_t)2048 * 1024 * 2;
constexpr size_t O_WOUT = O_WONB + (size_t)2048 * 1024 * 2;
constexpr size_t O_WXQ = O_WOUT + (size_t)2048 * 2048 * 2;
constexpr size_t O_WXKV = O_WXQ + (size_t)512 * 2048 * 2;
constexpr size_t O_WXO = O_WXKV + (size_t)1024 * 2048 * 2;
constexpr size_t O_WFF1 = O_WXO + (size_t)2048 * 512 * 2;
constexpr size_t O_WFF2 = O_WFF1 + (size_t)8192 * 2048 * 2;
constexpr size_t O_BIASK = O_WFF2 + (size_t)2048 * 8192 * 2;
constexpr size_t O_COSA = al256(O_BIASK + 1024);
constexpr size_t O_SINA = O_COSA + (size_t)SEQ * 12 * 4;
constexpr size_t O_COSB = O_SINA + (size_t)SEQ * 12 * 4;
constexpr size_t O_SINB = O_COSB + (size_t)SEQ * 16 * 4;
constexpr size_t O_SSQ = O_SINB + (size_t)SEQ * 16 * 4;
constexpr size_t O_MEMN = O_SSQ + (size_t)5 * T * 4;
constexpr size_t O_KMEM = O_MEMN + (size_t)1024 * 2048 * 2;
constexpr size_t O_VMEM = O_KMEM + (size_t)1024 * 512 * 2;
constexpr size_t O_KCC = O_VMEM + (size_t)1024 * 512 * 2;
constexpr size_t O_VCC = O_KCC + (size_t)4 * 512 * 4 * 96 * 2;
constexpr size_t O_HK = O_VCC + (size_t)4 * 512 * 4 * 64 * 2;
constexpr size_t O_HV = O_HK + (size_t)8192 * 96 * 2;
constexpr size_t O_SEL = O_HV + (size_t)8192 * 64 * 2;
constexpr size_t O_GN = O_SEL + (size_t)T * 4 * 16;
constexpr size_t O_XN = al256(O_GN + (size_t)T * 48 * 4);
constexpr size_t O_OACC = O_XN + (size_t)T * 2048 * 2;
constexpr size_t O_OB = O_OACC + (size_t)T * 1024 * 4;
constexpr size_t O_R = O_OB + (size_t)T * 1024 * 2;
constexpr size_t O_QA = O_R;
constexpr size_t O_KS = O_QA + (size_t)T * 1536 * 2;
constexpr size_t O_VS = O_KS + (size_t)T * 384 * 2;
constexpr size_t O_KC = O_VS + (size_t)T * 256 * 2;
constexpr size_t O_KW = O_KC + (size_t)T * 384 * 2;
constexpr size_t O_VC = O_KW + (size_t)T * 384 * 2;
constexpr size_t O_VW = O_VC + (size_t)T * 256 * 2;
constexpr size_t O_CQ = O_VW + (size_t)T * 256 * 2;
constexpr size_t O_CKV = O_CQ + (size_t)T * 512 * 2;
constexpr size_t O_QMLA = O_CKV + (size_t)T * 256 * 2;
constexpr size_t O_KMLA = O_QMLA + (size_t)T * 1536 * 2;
constexpr size_t O_VMLA = O_KMLA + (size_t)T * 1536 * 2;
constexpr size_t O_END = O_VMLA + (size_t)T * 1024 * 2;
constexpr size_t O_OA = O_KC;
constexpr size_t O_GATES = O_QMLA;
constexpr size_t O_MIXED = O_QA;
constexpr size_t O_QX = O_KC;
constexpr size_t O_OX = O_KC + (size_t)T * 512 * 2;
constexpr size_t O_U = O_R;
static_assert(O_GATES + (size_t)T * 4096 * 2 <= O_END, "gates alias");
static_assert(O_U + (size_t)T * 8192 * 2 <= O_END, "u alias");
constexpr size_t O_BAR = O_END;
constexpr int XCD_BAR_WORDS = 3456;
constexpr size_t O_END2 = O_BAR + (size_t)XCD_BAR_WORDS * 4;
static_assert(O_END2 <= (size_t)1073741824, "workspace");

struct Params {
    const float *x, *mem, *g_mix, *w_in, *cmp_pos_k, *cmp_w1_k, *cmp_w2_k, *cmp_pos_v, *cmp_w1_v, *cmp_w2_v,
        *mla_g_q, *mla_w_uq, *mla_g_kv, *mla_w_uk, *mla_w_uv, *w_o_nsa, *w_o_mla, *w_out, *g_xattn, *g_mem,
        *xa_wq, *xa_wkv, *xa_wo, *g_mlp, *w_ff1, *w_ff2, *g_final;
    float* out;
    unsigned char* ws;
    int ph_lo, ph_hi;
};

DI float bf2f(unsigned b) { return __uint_as_float(b << 16); }
typedef float f32x2_t __attribute__((ext_vector_type(2)));
typedef __bf16 bf16x2_t __attribute__((ext_vector_type(2)));
DI unsigned pk2(float lo, float hi) { const f32x2_t v = {lo, hi}; return __builtin_bit_cast(unsigned, __builtin_convertvector(v, bf16x2_t)); }
DI bf16_t f2bf(float f) { return (bf16_t)(pk2(f, 0.f) & 0xffffu); }
DI float ex2(float x) { return __builtin_amdgcn_exp2f(x); }
DI float sigm(float x) { return __builtin_amdgcn_rcpf(1.f + __builtin_amdgcn_exp2f(-1.4426950408889634f * x)); }
DI float wave_sum(float v) {
#pragma unroll
    for (int o = 32; o > 0; o >>= 1) v += __shfl_xor(v, o);
    return v;
}
DI int permNSA(int p) { return p < 24 ? ((p & 1) ? 12 + (p >> 1) : (p >> 1)) : p; }
DI int permMLA(int p) { return (p & 1) ? 16 + (p >> 1) : (p >> 1); }
DI u32x4 pack8(f32x4 a, f32x4 b) { u32x4 w; w.x = pk2(a[0], a[1]); w.y = pk2(a[2], a[3]); w.z = pk2(b[0], b[1]); w.w = pk2(b[2], b[3]); return w; }
DI void unpack8(u32x4 w, f32x4& a, f32x4& b) {
    a[0] = bf2f(w.x & 0xffffu); a[1] = bf2f(w.x >> 16); a[2] = bf2f(w.y & 0xffffu); a[3] = bf2f(w.y >> 16);
    b[0] = bf2f(w.z & 0xffffu); b[1] = bf2f(w.z >> 16); b[2] = bf2f(w.w & 0xffffu); b[3] = bf2f(w.w >> 16);
}
DI void rope8(f32x4& a, f32x4& b, f32x4 c, f32x4 s) {
    float o0 = a[0] * c[0] - a[1] * s[0], o1 = a[0] * s[0] + a[1] * c[0];
    float o2 = a[2] * c[1] - a[3] * s[1], o3 = a[2] * s[1] + a[3] * c[1];
    float o4 = b[0] * c[2] - b[1] * s[2], o5 = b[0] * s[2] + b[1] * c[2];
    float o6 = b[2] * c[3] - b[3] * s[3], o7 = b[2] * s[3] + b[3] * c[3];
    a[0] = o0; a[1] = o1; a[2] = o2; a[3] = o3; b[0] = o4; b[1] = o5; b[2] = o6; b[3] = o7;
}
DI float sumsq8(f32x4 a, f32x4 b) { return a[0]*a[0] + a[1]*a[1] + a[2]*a[2] + a[3]*a[3] + b[0]*b[0] + b[1]*b[1] + b[2]*b[2] + b[3]*b[3]; }

namespace pg8 {
constexpr int BM = 256, BK = 64, HALF = 128, HTB = HALF * BK * 2, STAGE_BYTES = 8 * HTB, NXCD = 8, WGM = 8;
DI int lds_byte(int r, int c) { const int st = (r >> 4) * 2 + (c >> 5), rr = r & 15, cc = c & 31, ob = rr * 64 + cc * 2; return st * 1024 + (ob ^ (((ob >> 9) & 1) << 5)); }
DI void stage_rc(int b, int& R, int& C) { const int st = b / 1024, sb = b % 1024, swz = sb ^ (((sb >> 9) & 1) << 5); R = (st >> 1) * 16 + swz / 64; C = (st & 1) * 32 + (swz % 64) / 2; }
DI int perm32(int rho) { const int n = rho >> 4, i = rho & 15; return 8 * (i >> 2) + 4 * n + (i & 3); }
struct Unit { int pm, pn; };
struct Gemm { const bf16_t* A; const bf16_t* Bt; int M, N, K; };
struct StaticOrder {
    int nM, nN, nwg, G, c;
    DI void init(int M, int N, int G_, int c_) { nM = M / BM; nN = N / BM; nwg = nM * nN; G = G_; c = c_; }
    DI bool next(int i, Unit& u) const {
        const long L = (long)i * G + c; if (L >= nwg) return false;
        int wgid = (int)L; { const int q = nwg / NXCD, r = nwg % NXCD, xcd = wgid % NXCD, off = wgid / NXCD; wgid = (xcd < r ? xcd * (q + 1) : r * (q + 1) + (xcd - r) * q) + off; }
        const int nig = WGM * nN, gid = wgid / nig, fm = gid * WGM, gsz = (nM - fm) < WGM ? (nM - fm) : WGM;
        u.pm = fm + ((wgid % nig) % gsz); u.pn = (wgid % nig) / gsz; return true;
    }
};

template <class Epi>
DI void gemm_phase(LAS unsigned char* lds, const Gemm g, const StaticOrder& S, const Epi& E) {
    const int tid = threadIdx.x, wid = __builtin_amdgcn_readfirstlane(tid >> 6), lane = tid & 63, wr = wid >> 2, wc = wid & 3, fr = lane & 15, fq = lane >> 4;
    const int K = g.K, nt = K / BK;
    unsigned voffA[2], voffB[2];
#pragma unroll
    for (int i = 0; i < 2; ++i) { int R, C; stage_rc(tid * 16 + i * 8192, R, C); const int Rb = (R & ~31) + perm32(R & 31);
        voffA[i] = (unsigned)(R * K + C) * 2u; voffB[i] = (unsigned)(Rb * K + C) * 2u; }
    const size_t kstep = (size_t)(BK * 2);
    const size_t hstep = (size_t)HALF * K * 2;
    const size_t tstep = 2 * hstep;
    const unsigned ldsw = (unsigned)wid * 1024u;
    const int aoff = lds_byte(wr * 64 + fr, fq * 8), boff = lds_byte(wc * 32 + fr, fq * 8);
#define PG8_SA(b, h) (((b) * 2 + (h)) * HTB)
#define PG8_SB(b, h) ((4 + (b) * 2 + (h)) * HTB)
#define PG8_STAGE(bufoff, gbase, voff) do { _Pragma("unroll") for (int _i = 0; _i < 2; ++_i) \
        __builtin_amdgcn_global_load_lds((const unsigned*)((const char*)(gbase) + (voff)[_i]), (LAS unsigned*)(lds + (bufoff) + ldsw + _i * 8192), 16, 0, 0); } while (0)
#define PG8_LDA(dst, b, h) do { _Pragma("unroll") for (int m = 0; m < 4; ++m) _Pragma("unroll") for (int k = 0; k < 2; ++k) dst[m][k] = *(const LAS bf16x8*)(lds + PG8_SA(b, h) + aoff + m * 2048 + k * 1024); } while (0)
#define PG8_LDB(dst, b, h) do { _Pragma("unroll") for (int n = 0; n < 2; ++n) _Pragma("unroll") for (int k = 0; k < 2; ++k) dst[n][k] = *(const LAS bf16x8*)(lds + PG8_SB(b, h) + boff + n * 2048 + k * 1024); } while (0)
#define PG8_MMA(ai, bj, At, Bt) do { __builtin_amdgcn_s_setprio(1); _Pragma("unroll") for (int m = 0; m < 4; ++m) _Pragma("unroll") for (int n = 0; n < 2; ++n) _Pragma("unroll") for (int k = 0; k < 2; ++k) \
        acc[ai][bj][m][n] = __builtin_amdgcn_mfma_f32_16x16x32_bf16(Bt[n][k], At[m][k], acc[ai][bj][m][n], 0, 0, 0); __builtin_amdgcn_s_setprio(0); } while (0)
#define PG8_WAIT_V(n) asm volatile("s_waitcnt vmcnt(" #n ")" ::: "memory")
#define PG8_WAIT_L(n) asm volatile("s_waitcnt lgkmcnt(" #n ")" ::: "memory")
#define PG8_BAR __builtin_amdgcn_s_barrier()
#define PG8_SCHED __builtin_amdgcn_sched_barrier(0)
    Unit cur, nxt; int ui = 0;
    if (!S.next(0, cur)) return;
    f32x4 acc[2][2][4][2];
#pragma unroll
    for (int a = 0; a < 2; ++a)
#pragma unroll
        for (int b = 0; b < 2; ++b)
#pragma unroll
            for (int m = 0; m < 4; ++m)
#pragma unroll
                for (int n = 0; n < 2; ++n) acc[a][b][m][n] = (f32x4){0.f, 0.f, 0.f, 0.f};
    bf16x8 At[4][2], B0[2][2], B1[2][2];
    const char* cA = (const char*)g.A + (size_t)cur.pm * tstep; const char* cB = (const char*)g.Bt + (size_t)cur.pn * tstep;
    PG8_STAGE(PG8_SB(0, 0), cB, voffB); PG8_STAGE(PG8_SA(0, 0), cA, voffA); PG8_STAGE(PG8_SB(0, 1), cB + hstep, voffB); PG8_STAGE(PG8_SA(0, 1), cA + hstep, voffA);
    if (wr == 1) PG8_BAR;
    PG8_WAIT_V(4); PG8_BAR;
    PG8_STAGE(PG8_SB(1, 0), cB + kstep, voffB); PG8_STAGE(PG8_SA(1, 0), cA + kstep, voffA); PG8_STAGE(PG8_SB(1, 1), cB + hstep + kstep, voffB);
    PG8_WAIT_V(6); PG8_BAR;
    for (;;) {
        const bool has_next = S.next(ui + 1, nxt);
        const char* nA = has_next ? (const char*)g.A + (size_t)nxt.pm * tstep : cA; const char* nB = has_next ? (const char*)g.Bt + (size_t)nxt.pn * tstep : cB;
#pragma unroll 1
        for (int t = 0; t < nt; t += 2) {
            const bool last = (t == nt - 2);
            const char* a1 = cA + (size_t)(t + 1) * kstep;
            const char* a2 = last ? nA : cA + (size_t)(t + 2) * kstep; const char* b2 = last ? nB : cB + (size_t)(t + 2) * kstep;
            const char* a3 = a2 + kstep; const char* b3 = b2 + kstep;
            PG8_LDB(B0, 0, 0); PG8_SCHED; PG8_LDA(At, 0, 0); PG8_STAGE(PG8_SA(1, 1), a1 + hstep, voffA);
            PG8_WAIT_L(8); PG8_BAR; PG8_WAIT_L(0); PG8_MMA(0, 0, At, B0); PG8_BAR; PG8_SCHED;
            PG8_LDB(B1, 0, 1); PG8_STAGE(PG8_SB(0, 0), b2, voffB);
            PG8_BAR; PG8_WAIT_L(0); PG8_MMA(0, 1, At, B1); PG8_BAR;
            PG8_LDA(At, 0, 1); PG8_STAGE(PG8_SA(0, 0), a2, voffA);
            PG8_BAR; PG8_WAIT_L(0); PG8_MMA(1, 0, At, B0); PG8_BAR; PG8_SCHED;
            PG8_STAGE(PG8_SB(0, 1), b2 + hstep, voffB);
            PG8_WAIT_V(6); PG8_BAR; PG8_MMA(1, 1, At, B1); PG8_BAR;
            PG8_LDB(B0, 1, 0); PG8_SCHED; PG8_LDA(At, 1, 0); PG8_STAGE(PG8_SA(0, 1), a2 + hstep, voffA);
            PG8_WAIT_L(8); PG8_BAR; PG8_WAIT_L(0); PG8_MMA(0, 0, At, B0); PG8_BAR; PG8_SCHED;
            PG8_LDB(B1, 1, 1); PG8_STAGE(PG8_SB(1, 0), b3, voffB);
            PG8_BAR; PG8_WAIT_L(0); PG8_MMA(0, 1, At, B1); PG8_BAR;
            PG8_LDA(At, 1, 1); PG8_STAGE(PG8_SA(1, 0), a3, voffA);
            PG8_BAR; PG8_WAIT_L(0); PG8_MMA(1, 0, At, B0); PG8_BAR; PG8_SCHED;
            PG8_STAGE(PG8_SB(1, 1), b3 + hstep, voffB);
            PG8_WAIT_V(6); PG8_BAR; PG8_MMA(1, 1, At, B1); PG8_BAR;
        }
        E(acc, cur, wr, wc, fr, fq);
        if (!has_next) break;
#pragma unroll
        for (int a = 0; a < 2; ++a)
#pragma unroll
            for (int b = 0; b < 2; ++b)
#pragma unroll
                for (int m = 0; m < 4; ++m)
#pragma unroll
                    for (int n = 0; n < 2; ++n) acc[a][b][m][n] = (f32x4){0.f, 0.f, 0.f, 0.f};
        cur = nxt; cA = nA; cB = nB; ++ui;
    }
    PG8_WAIT_V(0);
    if (wr == 0) PG8_BAR;
    PG8_BAR;
#undef PG8_SA
#undef PG8_SB
#undef PG8_STAGE
#undef PG8_LDA
#undef PG8_LDB
#undef PG8_MMA
#undef PG8_WAIT_V
#undef PG8_WAIT_L
#undef PG8_BAR
#undef PG8_SCHED
}
}

struct NoPre {};
template <class F> struct EpiT {
    F f;
    DI void operator()(const f32x4 (&acc)[2][2][4][2], const pg8::Unit& u, int wr, int wc, int fr, int fq) const {
#pragma unroll
        for (int ai = 0; ai < 2; ++ai) {
            typename F::Pre pre[4][2];
#pragma unroll
            for (int m = 0; m < 4; ++m)
#pragma unroll
                for (int bj = 0; bj < 2; ++bj) pre[m][bj] = f.load(u.pm * 256 + ai * 128 + wr * 64 + m * 16 + fr, u.pn * 256 + bj * 128 + wc * 32 + 8 * fq);
#pragma unroll
            for (int m = 0; m < 4; ++m)
#pragma unroll
                for (int bj = 0; bj < 2; ++bj) f.apply(u.pm * 256 + ai * 128 + wr * 64 + m * 16 + fr, u.pn * 256 + bj * 128 + wc * 32 + 8 * fq, acc[ai][bj][m][0], acc[ai][bj][m][1], pre[m][bj]);
        }
    }
};
template <class F> DI void run_gemm(LAS unsigned char* lds, const bf16_t* A, const bf16_t* Bt, int M, int N, int K, const F& f, int rot) {
    pg8::Gemm g{A, Bt, M, N, K}; pg8::StaticOrder S; S.init(M, N, (int)gridDim.x, (int)((blockIdx.x + rot) % gridDim.x));
    EpiT<F> E{f};
    pg8::gemm_phase(lds, g, S, E);
}

struct FGemm1 {
    unsigned char* ws; int col0;
    typedef NoPre Pre; DI Pre load(int, int) const { return Pre{}; }
    DI void apply(int row, int gc0, f32x4 a, f32x4 b, const Pre&) const {
        const int gc = gc0 + col0;
        const int pos = row & (SEQ - 1);
        if (gc < 2688) {
            const int m = gc < 1536 ? gc : gc - 1536;
            const int p = m % 96;
            if (p < 24) rope8(a, b, *(const f32x4*)((const float*)(ws + O_COSA) + pos * 12 + (p >> 1)), *(const f32x4*)((const float*)(ws + O_SINA) + pos * 12 + (p >> 1)));
            size_t off;
            if (gc < 1536) off = O_QA + ((size_t)row * 1536 + gc) * 2;
            else { const int seg = m / 384, c = m % 384; off = (seg == 0 ? O_KC : (seg == 1 ? O_KS : O_KW)) + ((size_t)row * 384 + c) * 2; }
            *(u32x4*)(ws + off) = pack8(a, b);
        } else if (gc < 3456) {
            const int m = gc - 2688, seg = m >> 8, c = m & 255;
            const size_t off = (seg == 0 ? O_VC : (seg == 1 ? O_VS : O_VW)) + ((size_t)row * 256 + c) * 2;
            *(u32x4*)(ws + off) = pack8(a, b);
        } else if (gc < 3712) {
            *(u32x4*)(ws + O_CKV + ((size_t)row * 256 + (gc - 3456)) * 2) = pack8(a, b);
            float s = sumsq8(a, b); s += __shfl_xor(s, 16); s += __shfl_xor(s, 32);
            if ((threadIdx.x & 63) < 16) atomicAdd((float*)(ws + O_SSQ) + T + row, s);
        } else if (gc < 3744) {
            const int p = gc - 3712;
            rope8(a, b, *(const f32x4*)((const float*)(ws + O_COSB) + pos * 16 + (p >> 1)), *(const f32x4*)((const float*)(ws + O_SINB) + pos * 16 + (p >> 1)));
            const u32x4 w = pack8(a, b);
            bf16_t* d = (bf16_t*)(ws + O_KMLA) + (size_t)row * 1536 + 64 + p;
            for (int h = 0; h < 16; ++h) *(u32x4*)(d + h * 96) = w;
        } else if (gc < 3792) {
            float* d = (float*)(ws + O_GN) + (size_t)row * 48 + (gc - 3744);
            *(f32x4*)d = (f32x4){sigm(a[0]), sigm(a[1]), sigm(a[2]), sigm(a[3])};
            *(f32x4*)(d + 4) = (f32x4){sigm(b[0]), sigm(b[1]), sigm(b[2]), sigm(b[3])};
        } else if (gc >= 3840) {
            *(u32x4*)(ws + O_CQ + ((size_t)row * 512 + (gc - 3840)) * 2) = pack8(a, b);
            float s = sumsq8(a, b); s += __shfl_xor(s, 16); s += __shfl_xor(s, 32);
            if ((threadIdx.x & 63) < 16) atomicAdd((float*)(ws + O_SSQ) + row, s);
        }
    }
};
struct FMemKV { bf16_t *Km, *Vm;
    typedef NoPre Pre; DI Pre load(int, int) const { return Pre{}; }
    DI void apply(int row, int gc, f32x4 a, f32x4 b, const Pre&) const {
        bf16_t* d = gc < 512 ? Km + (size_t)row * 512 + gc : Vm + (size_t)row * 512 + (gc - 512);
        *(u32x4*)d = pack8(a, b); } };
struct FUq { unsigned char* ws;
    typedef float Pre; DI Pre load(int row, int) const { return ((const float*)(ws + O_SSQ))[row]; }
    DI void apply(int row, int gc, f32x4 a, f32x4 b, const Pre& pre) const {
        const float rs = rsqrtf(pre * (1.f / 512.f) + EPS); a *= rs; b *= rs;
        const int p = gc % 96, pos = row & (SEQ - 1);
        if (p >= 64) rope8(a, b, *(const f32x4*)((const float*)(ws + O_COSB) + pos * 16 + ((p - 64) >> 1)), *(const f32x4*)((const float*)(ws + O_SINB) + pos * 16 + ((p - 64) >> 1)));
        *(u32x4*)(ws + O_QMLA + ((size_t)row * 1536 + gc) * 2) = pack8(a, b); } };
struct FUkv { unsigned char* ws;
    typedef float Pre; DI Pre load(int row, int) const { return ((const float*)(ws + O_SSQ))[T + row]; }
    DI void apply(int row, int gc, f32x4 a, f32x4 b, const Pre& pre) const {
        const float rs = rsqrtf(pre * (1.f / 256.f) + EPS); a *= rs; b *= rs;
        const size_t off = gc < 1024 ? O_KMLA + ((size_t)row * 1536 + (gc >> 6) * 96 + (gc & 63)) * 2 : O_VMLA + ((size_t)row * 1024 + (gc - 1024)) * 2;
        *(u32x4*)(ws + off) = pack8(a, b); } };
struct FGate { bf16_t* g;
    typedef NoPre Pre; DI Pre load(int, int) const { return Pre{}; }
    DI void apply(int row, int gc, f32x4 a, f32x4 b, const Pre&) const {
#pragma unroll
        for (int i = 0; i < 4; ++i) { a[i] = sigm(a[i]); b[i] = sigm(b[i]); }
        *(u32x4*)(g + (size_t)row * 4096 + gc) = pack8(a, b); } };
template <int SECOND> struct FMix { const bf16_t* g; bf16_t* mixed;
    struct Pre { u32x4 g, mx; };
    DI Pre load(int row, int gc) const { Pre p; p.g = *(const u32x4*)(g + (size_t)row * 4096 + SECOND * 2048 + gc); if (SECOND) p.mx = *(const u32x4*)(mixed + (size_t)row * 2048 + gc); return p; }
    DI void apply(int row, int gc, f32x4 a, f32x4 b, const Pre& pre) const {
        f32x4 ga, gb; unpack8(pre.g, ga, gb);
        a *= ga; b *= gb;
        if (SECOND) { f32x4 pa, pb; unpack8(pre.mx, pa, pb); a += pa; b += pb; }
        *(u32x4*)(mixed + (size_t)row * 2048 + gc) = pack8(a, b); } };
template <int MODE> struct FResid { const float* base; float* out; bf16_t* hb; float* ssq;
    struct Pre { f32x4 a, b; u32x4 h; };
    DI Pre load(int row, int gc) const { Pre p;
        if (MODE == 0) { const float* bp = base + (size_t)row * 2048 + gc; p.a = *(const f32x4*)bp; p.b = *(const f32x4*)(bp + 4); }
        else p.h = *(const u32x4*)(hb + (size_t)row * 2048 + gc);
        return p; }
    DI void apply(int row, int gc, f32x4 a, f32x4 b, const Pre& pre) const {
        if (MODE == 0) { a += pre.a; b += pre.b; }
        else { f32x4 pa, pb; unpack8(pre.h, pa, pb); a += pa; b += pb; }
        if (MODE == 2) { float* op = out + (size_t)row * 2048 + gc; *(f32x4*)op = a; *(f32x4*)(op + 4) = b; }
        else *(u32x4*)(hb + (size_t)row * 2048 + gc) = pack8(a, b);
        float s = sumsq8(a, b); s += __shfl_xor(s, 16); s += __shfl_xor(s, 32);
        if ((threadIdx.x & 63) < 16) atomicAdd(ssq + row, s); } };
struct FXq { bf16_t* q; const float* ssq;
    typedef float Pre; DI Pre load(int row, int) const { return ssq[row]; }
    DI void apply(int row, int gc, f32x4 a, f32x4 b, const Pre& pre) const {
        const float rs = rsqrtf(pre * (1.f / 2048.f) + EPS); a *= rs; b *= rs;
        *(u32x4*)(q + (size_t)row * 512 + gc) = pack8(a, b); } };
struct FFf1 { bf16_t* u; const float* ssq;
    typedef float Pre; DI Pre load(int row, int) const { return ssq[row]; }
    DI void apply(int row, int gc, f32x4 a, f32x4 b, const Pre& pre) const {
        const float rs = rsqrtf(pre * (1.f / 2048.f) + EPS);
#pragma unroll
        for (int i = 0; i < 4; ++i) { float z = fmaxf(a[i] * rs, 0.f); a[i] = z * z; z = fmaxf(b[i] * rs, 0.f); b[i] = z * z; }
        *(u32x4*)(u + (size_t)row * 8192 + gc) = pack8(a, b); } };

template <int NMAP> DI int nmap(int n) {
    if (NMAP == 0) return n;
    if (NMAP == 1) {
        if (n < 1536) { const int h = n / 96, p = n % 96; return h * 96 + permNSA(p); }
        if (n < 2688) { const int m = n - 1536, seg = m / 384, c = m % 384, hh = c / 96, p = c % 96; const int sb = seg == 0 ? 1536 : (seg == 1 ? 2176 : 2816); return sb + hh * 96 + permNSA(p); }
        if (n < 3456) { const int m = n - 2688, seg = m >> 8, c = m & 255; const int sb = seg == 0 ? 1920 : (seg == 1 ? 2560 : 3200); return sb + c; }
        if (n < 3712) return 4016 + (n - 3456);
        if (n < 3744) return 4272 + permMLA(n - 3712);
        if (n < 3792) return 3456 + (n - 3744);
        if (n < 3840) return -1;
        return 3504 + (n - 3840);
    }
    if (NMAP == 2) { const int h = n / 96, p = n % 96; return p < 64 ? n : h * 96 + 64 + permMLA(p - 64); }
    return n;
}
template <int KMAP> DI int kmap(int k) { if (KMAP == 1) { const int l = k / 96, p = k % 96; return l * 96 + permNSA(p); } return k; }

template <int NMAP, int KMAP>
DI void transpose_w(const float* __restrict__ src, int ldsrc, int K, bf16_t* __restrict__ dst, int Ndst, const float* __restrict__ kscale, LAS float* tile) {
    const int tn = (Ndst + 63) / 64, tk = K / 64, ntiles = tn * tk;
    if (NMAP == 0 && KMAP == 0) {
        for (int t = blockIdx.x; t < ntiles; t += gridDim.x) {
            const int in = t % tn, ik = t / tn;
#pragma unroll
            for (int i = 0; i < 2; ++i) { const int e = threadIdx.x + i * NTHREADS, kk = e >> 4, n4 = (e & 15) * 4, k = ik * 64 + kk, n = in * 64 + n4;
                f32x4 v = (f32x4){0.f, 0.f, 0.f, 0.f};
                if (n < Ndst) v = *(const f32x4*)(src + (size_t)k * ldsrc + n);
                if (kscale) v *= kscale[k];
                tile[kk * 65 + n4] = v[0]; tile[kk * 65 + n4 + 1] = v[1]; tile[kk * 65 + n4 + 2] = v[2]; tile[kk * 65 + n4 + 3] = v[3]; }
            __syncthreads();
            { const int nn = threadIdx.x >> 3, k8 = (threadIdx.x & 7) * 8, n = in * 64 + nn;
              u32x4 w; w.x = pk2(tile[(k8 + 0) * 65 + nn], tile[(k8 + 1) * 65 + nn]); w.y = pk2(tile[(k8 + 2) * 65 + nn], tile[(k8 + 3) * 65 + nn]);
              w.z = pk2(tile[(k8 + 4) * 65 + nn], tile[(k8 + 5) * 65 + nn]); w.w = pk2(tile[(k8 + 6) * 65 + nn], tile[(k8 + 7) * 65 + nn]);
              if (n < Ndst) *(u32x4*)(dst + (size_t)n * K + ik * 64 + k8) = w; }
            __syncthreads();
        }
        return;
    }
    for (int t = blockIdx.x; t < ntiles; t += gridDim.x) {
        const int in = t % tn, ik = t / tn;
        for (int e = threadIdx.x; e < 4096; e += NTHREADS) {
            const int kk = e >> 6, nn = e & 63, n = in * 64 + nn, k = ik * 64 + kk;
            const int sc = (n < Ndst) ? nmap<NMAP>(n) : -1;
            const int sr = kmap<KMAP>(k);
            float v = (sc >= 0) ? src[(size_t)sr * ldsrc + sc] : 0.f;
            if (kscale) v *= kscale[sr];
            tile[kk * 65 + nn] = v;
        }
        __syncthreads();
        for (int e = threadIdx.x; e < 2048; e += NTHREADS) {
            const int nn = e >> 5, k2 = (e & 31) * 2, n = in * 64 + nn;
            if (n < Ndst) *(unsigned*)(dst + (size_t)n * K + ik * 64 + k2) = pk2(tile[k2 * 65 + nn], tile[(k2 + 1) * 65 + nn]);
        }
        __syncthreads();
    }
}

DI void rmsnorm_rows(const float* __restrict__ src, const float* __restrict__ g, bf16_t* __restrict__ dst, int nrows) {
    const int lane = threadIdx.x & 63, gw = blockIdx.x * (NTHREADS / 64) + (threadIdx.x >> 6), nw = gridDim.x * (NTHREADS / 64);
    for (int row = gw; row < nrows; row += nw) {
        f32x4 v[8]; float ss = 0.f;
#pragma unroll
        for (int i = 0; i < 8; ++i) { v[i] = *(const f32x4*)(src + (size_t)row * 2048 + (i * 64 + lane) * 4); ss += v[i][0] * v[i][0] + v[i][1] * v[i][1] + v[i][2] * v[i][2] + v[i][3] * v[i][3]; }
        ss = wave_sum(ss);
        const float rs = rsqrtf(ss * (1.f / 2048.f) + EPS);
#pragma unroll
        for (int i = 0; i < 8; ++i) { const f32x4 gv = *(const f32x4*)(g + (i * 64 + lane) * 4);
            u32x2 w; w.x = pk2(v[i][0] * rs * gv[0], v[i][1] * rs * gv[1]); w.y = pk2(v[i][2] * rs * gv[2], v[i][3] * rs * gv[3]);
            *(u32x2*)(dst + (size_t)row * 2048 + (i * 64 + lane) * 4) = w; }
    }
}

DI void phase_prep(const Params& p, LAS unsigned char* lds) {
    unsigned char* ws = p.ws;
    LAS float* tile = (LAS float*)lds;
    const int gtid = blockIdx.x * NTHREADS + threadIdx.x, gsz = gridDim.x * NTHREADS;
    { float* z = (float*)(ws + O_SSQ); for (int i = gtid; i < 5 * T; i += gsz) z[i] = 0.f; }
    { float *cA = (float*)(ws + O_COSA), *sA = (float*)(ws + O_SINA), *cB = (float*)(ws + O_COSB), *sB = (float*)(ws + O_SINB);
      for (int i = gtid; i < SEQ * 12; i += gsz) { const int pos = i / 12, j = i % 12; const float inv = 1.0f / powf(500000.0f, (float)(2 * j) / 24.0f); const float ang = (float)pos * inv; cA[i] = cosf(ang); sA[i] = sinf(ang); }
      for (int i = gtid; i < SEQ * 16; i += gsz) { const int pos = i / 16, j = i % 16; const float inv = 1.0f / powf(500000.0f, (float)(2 * j) / 32.0f); const float ang = (float)pos * inv; cB[i] = cosf(ang); sB[i] = sinf(ang); } }
    if (blockIdx.x == 1 % gridDim.x) {
        const int n = threadIdx.x & 127, part = threadIdx.x >> 7;
        float s = 0.f;
        if (n < 96) for (int k = part * 768; k < (part + 1) * 768; ++k) s += p.cmp_pos_k[k] * p.cmp_w1_k[(size_t)k * 96 + n];
        tile[threadIdx.x] = s; __syncthreads();
        if (threadIdx.x < 96) ((float*)(ws + O_BIASK))[threadIdx.x] = tile[threadIdx.x] + tile[threadIdx.x + 128] + tile[threadIdx.x + 256] + tile[threadIdx.x + 384];
        __syncthreads();
        s = 0.f;
        if (n < 64) for (int k = part * 512; k < (part + 1) * 512; ++k) s += p.cmp_pos_v[k] * p.cmp_w1_v[(size_t)k * 64 + n];
        tile[threadIdx.x] = s; __syncthreads();
        if (threadIdx.x < 64) ((float*)(ws + O_BIASK))[96 + threadIdx.x] = tile[threadIdx.x] + tile[threadIdx.x + 128] + tile[threadIdx.x + 256] + tile[threadIdx.x + 384];
        __syncthreads();
    }
    if (blockIdx.x == 2 % gridDim.x) {
        bf16_t* w2k = (bf16_t*)(ws + O_W2K); bf16_t* w2v = (bf16_t*)(ws + O_W2V);
        for (int e = threadIdx.x; e < 96 * 96; e += NTHREADS) { const int n = e / 96, k = e % 96; w2k[e] = f2bf(p.cmp_w2_k[k * 96 + permNSA(n)]); }
        for (int e = threadIdx.x; e < 64 * 64; e += NTHREADS) { const int n = e >> 6, k = e & 63; w2v[e] = f2bf(p.cmp_w2_v[k * 64 + n]); }
    }
    rmsnorm_rows(p.x, p.g_mix, (bf16_t*)(ws + O_XN), T);
    rmsnorm_rows(p.mem, p.g_mem, (bf16_t*)(ws + O_MEMN), BATCH * MEM);
    transpose_w<1, 0>(p.w_in, DIN, 2048, (bf16_t*)(ws + O_WIN), 4352, nullptr, tile);
    transpose_w<0, 0>(p.w_in + 4304, DIN, 2048, (bf16_t*)(ws + O_WG), 4096, nullptr, tile);
    transpose_w<2, 0>(p.mla_w_uq, 1536, 512, (bf16_t*)(ws + O_WUQ), 1536, p.mla_g_q, tile);
    transpose_w<0, 0>(p.mla_w_uk, 1024, 256, (bf16_t*)(ws + O_WUK), 1024, p.mla_g_kv, tile);
    transpose_w<0, 0>(p.mla_w_uv, 1024, 256, (bf16_t*)(ws + O_WUV), 1024, p.mla_g_kv, tile);
    transpose_w<0, 1>(p.cmp_w1_k, 96, 3072, (bf16_t*)(ws + O_W1K), 96, nullptr, tile);
    transpose_w<0, 0>(p.cmp_w1_v, 64, 2048, (bf16_t*)(ws + O_W1V), 64, nullptr, tile);
    transpose_w<0, 0>(p.w_o_nsa, 2048, 1024, (bf16_t*)(ws + O_WONA), 2048, nullptr, tile);
    transpose_w<0, 0>(p.w_o_mla, 2048, 1024, (bf16_t*)(ws + O_WONB), 2048, nullptr, tile);
    transpose_w<0, 0>(p.w_out, 2048, 2048, (bf16_t*)(ws + O_WOUT), 2048, nullptr, tile);
    transpose_w<0, 0>(p.xa_wq, 512, 2048, (bf16_t*)(ws + O_WXQ), 512, p.g_xattn, tile);
    transpose_w<0, 0>(p.xa_wkv, 1024, 2048, (bf16_t*)(ws + O_WXKV), 1024, nullptr, tile);
    transpose_w<0, 0>(p.xa_wo, 2048, 512, (bf16_t*)(ws + O_WXO), 2048, nullptr, tile);
    transpose_w<0, 0>(p.w_ff1, 8192, 2048, (bf16_t*)(ws + O_WFF1), 8192, p.g_mlp, tile);
    transpose_w<0, 0>(p.w_ff2, 2048, 8192, (bf16_t*)(ws + O_WFF2), 2048, nullptr, tile);
}

DI float gelu_tanh(float x) { const float u = 0.7978845608028654f * (x + 0.044715f * x * x * x); return 0.5f * x * (1.f + tanhf(u)); }

template <int DH> DI void compress_stage1(const bf16_t* __restrict__ X  , const bf16_t* __restrict__ W1t  , const float* __restrict__ bias, bf16_t* __restrict__ H, int task) {
    constexpr int NB = DH / 16, SPL = DH / 32;
    const int lane = threadIdx.x & 63, fr = lane & 15, fq = lane >> 4;
    const int bg = task >> 5, ct = task & 31, b = bg >> 2, g = bg & 3;
    int c = ct * 16 + fr; if (c > 510) c = 510;
    const bf16_t* arow = X + ((size_t)(b * SEQ + 16 * c) * 4 + g) * DH + 8 * fq;
    const bf16_t* brow = W1t + (size_t)fr * (32 * DH) + 8 * fq;
    f32x4 acc[NB];
#pragma unroll
    for (int n = 0; n < NB; ++n) acc[n] = (f32x4){0.f, 0.f, 0.f, 0.f};
    for (int l = 0; l < 32; ++l) {
#pragma unroll
        for (int s2 = 0; s2 < SPL; ++s2) {
            const bf16x8 a = *(const bf16x8*)(arow + (size_t)l * 4 * DH + s2 * 32);
            const int koff = l * DH + s2 * 32;
#pragma unroll
            for (int n = 0; n < NB; ++n) { const bf16x8 bb = *(const bf16x8*)(brow + (size_t)n * 16 * (32 * DH) + koff);
                acc[n] = __builtin_amdgcn_mfma_f32_16x16x32_bf16(a, bb, acc[n], 0, 0, 0); }
        }
    }
#pragma unroll
    for (int n = 0; n < NB; ++n)
#pragma unroll
        for (int j = 0; j < 4; ++j) { const int cc = ct * 16 + fq * 4 + j, col = n * 16 + fr;
            H[((size_t)(b * 512 + cc) * 4 + g) * DH + col] = f2bf(gelu_tanh(acc[n][j] + bias[col])); }
}
template <int DH> DI void compress_stage2(const bf16_t* __restrict__ H, const bf16_t* __restrict__ W2t  , bf16_t* __restrict__ O, int task) {
    constexpr int NB = DH / 16, KS = DH / 32;
    const int lane = threadIdx.x & 63, fr = lane & 15, fq = lane >> 4;
    const int bg = task >> 5, ct = task & 31, b = bg >> 2, g = bg & 3;
    int c = ct * 16 + fr; if (c > 510) c = 510;
    const bf16_t* arow = H + ((size_t)(b * 512 + c) * 4 + g) * DH + 8 * fq;
    f32x4 acc[NB];
#pragma unroll
    for (int n = 0; n < NB; ++n) acc[n] = (f32x4){0.f, 0.f, 0.f, 0.f};
#pragma unroll
    for (int s = 0; s < KS; ++s) { const bf16x8 a = *(const bf16x8*)(arow + s * 32);
#pragma unroll
        for (int n = 0; n < NB; ++n) { const bf16x8 bb = *(const bf16x8*)(W2t + (size_t)(n * 16 + fr) * DH + s * 32 + 8 * fq);
            acc[n] = __builtin_amdgcn_mfma_f32_16x16x32_bf16(a, bb, acc[n], 0, 0, 0); } }
#pragma unroll
    for (int n = 0; n < NB; ++n)
#pragma unroll
        for (int j = 0; j < 4; ++j) { const int cc = ct * 16 + fq * 4 + j, col = n * 16 + fr;
            O[((size_t)(b * 512 + cc) * 4 + g) * DH + col] = (cc > 510) ? (bf16_t)0 : f2bf(acc[n][j]); }
}

template <int DK, int DV> struct ALay {
    static constexpr int KSB = DK * 2 + 16, VSB = DV * 2 + 64;
    static constexpr int KBYTES = 64 * KSB, VBYTES = 64 * VSB, BUF = KBYTES + VBYTES;
    static constexpr int NPK = 64 * DK / 8, NPV = 64 * DV / 8;
    static constexpr int KI = (NPK + NTHREADS - 1) / NTHREADS, VI = (NPV + NTHREADS - 1) / NTHREADS;
};
constexpr int IMPS = 129;
constexpr int LDS_IMP = 77824, LDS_UNI = 77824 + 64 * 129 * 4 + 256;

template <int DK, int DV>
DI void tile_load(const bf16_t* __restrict__ Kt, int kstride, const bf16_t* __restrict__ Vt, int vstride, u32x4 (&kr)[ALay<DK, DV>::KI], u32x4 (&vr)[ALay<DK, DV>::VI]) {
    using L = ALay<DK, DV>;
#pragma unroll
    for (int i = 0; i < L::KI; ++i) { const int pi = threadIdx.x + i * NTHREADS; if (pi < L::NPK) { const int row = pi / (DK / 8), ch = pi % (DK / 8); kr[i] = *(const u32x4*)(Kt + (size_t)row * kstride + ch * 8); } }
#pragma unroll
    for (int i = 0; i < L::VI; ++i) { const int pi = threadIdx.x + i * NTHREADS; if (pi < L::NPV) { const int row = pi / (DV / 8), ch = pi % (DV / 8); vr[i] = *(const u32x4*)(Vt + (size_t)row * vstride + ch * 8); } }
}
template <int DK, int DV>
DI void tile_store(LAS unsigned char* kb, const u32x4 (&kr)[ALay<DK, DV>::KI], const u32x4 (&vr)[ALay<DK, DV>::VI]) {
    using L = ALay<DK, DV>;
#pragma unroll
    for (int i = 0; i < L::KI; ++i) { const int pi = threadIdx.x + i * NTHREADS; if (pi < L::NPK) { const int row = pi / (DK / 8), ch = pi % (DK / 8); *(LAS u32x4*)(kb + row * L::KSB + ch * 16) = kr[i]; } }
#pragma unroll
    for (int i = 0; i < L::VI; ++i) { const int pi = threadIdx.x + i * NTHREADS; if (pi < L::NPV) { const int row = pi / (DV / 8), ch = pi % (DV / 8); *(LAS u32x4*)(kb + L::KBYTES + row * L::VSB + ch * 16) = vr[i]; } }
}

struct AttnIn {
    const bf16_t* q;
    const bf16_t *K, *V;
    int kstride, vstride;
    int jlo, jhi;
    int t;
    int tw_lo, tw_hi;
    float sc;
    unsigned long long sel_lo, sel_hi;
    unsigned long long wsel_lo, wsel_hi;
    int tt;
};

template <int MODE> DI bool key_ok(int key, int t) {
    if (MODE == 0 || MODE == 3) return key <= t;
    if (MODE == 1) return key <= t && key >= t - 511;
    if (MODE == 2) return 16 * key + 31 <= t;
    return true;
}

template <int DK, int DV>
DI void tile_pv(LAS unsigned char* kb, const f32x16& S0, const f32x16& S1, f32x16 (&O)[DV / 32]) {
    using L = ALay<DK, DV>;
    const int lane = threadIdx.x & 63, h = lane >> 5, i16 = lane & 15, q4 = i16 >> 2, p4 = i16 & 3, g16 = lane >> 4;
    LAS unsigned char* vb_ = kb + L::KBYTES;
    __builtin_amdgcn_s_setprio(1);
#pragma unroll
    for (int kb2 = 0; kb2 < 2; ++kb2)
#pragma unroll
        for (int s2 = 0; s2 < 2; ++s2) {
            u32x4 pw;
            if (kb2 == 0) { pw.x = pk2(S0[8 * s2 + 0], S0[8 * s2 + 1]); pw.y = pk2(S0[8 * s2 + 2], S0[8 * s2 + 3]); pw.z = pk2(S0[8 * s2 + 4], S0[8 * s2 + 5]); pw.w = pk2(S0[8 * s2 + 6], S0[8 * s2 + 7]); }
            else          { pw.x = pk2(S1[8 * s2 + 0], S1[8 * s2 + 1]); pw.y = pk2(S1[8 * s2 + 2], S1[8 * s2 + 3]); pw.z = pk2(S1[8 * s2 + 4], S1[8 * s2 + 5]); pw.w = pk2(S1[8 * s2 + 6], S1[8 * s2 + 7]); }
            const bf16x8 pb = __builtin_bit_cast(bf16x8, pw);
            const int vrow = 32 * kb2 + 16 * s2 + 4 * h + q4;
#pragma unroll
            for (int d = 0; d < DV / 32; ++d) {
                const int vcol = d * 32 + 16 * (g16 & 1) + 4 * p4;
                const s16x4 lo = __builtin_amdgcn_ds_read_tr16_b64_v4i16((LAS s16x4*)(vb_ + vrow * L::VSB + vcol * 2));
                const s16x4 hi = __builtin_amdgcn_ds_read_tr16_b64_v4i16((LAS s16x4*)(vb_ + (vrow + 8) * L::VSB + vcol * 2));
                bf16x8 va; va[0] = lo[0]; va[1] = lo[1]; va[2] = lo[2]; va[3] = lo[3]; va[4] = hi[0]; va[5] = hi[1]; va[6] = hi[2]; va[7] = hi[3];
                O[d] = __builtin_amdgcn_mfma_f32_32x32x16_bf16(va, pb, O[d], 0, 0, 0);
            }
        }
    __builtin_amdgcn_s_setprio(0);
}

template <int DK, int DV>
DI void tile_qk(LAS unsigned char* kb, const bf16x8 (&qf)[DK / 16], f32x16& S0, f32x16& S1) {
    using L = ALay<DK, DV>;
    const int lane = threadIdx.x & 63, r = lane & 31, h = lane >> 5;
    const f32x16 z16 = {0.f, 0.f, 0.f, 0.f, 0.f, 0.f, 0.f, 0.f, 0.f, 0.f, 0.f, 0.f, 0.f, 0.f, 0.f, 0.f};
    __builtin_amdgcn_s_setprio(1);
#pragma unroll
    for (int s = 0; s < DK / 16; ++s) {
        const bf16x8 a0 = *(const LAS bf16x8*)(kb + r * L::KSB + (16 * s + 8 * h) * 2);
        const bf16x8 a1 = *(const LAS bf16x8*)(kb + (32 + r) * L::KSB + (16 * s + 8 * h) * 2);
        S0 = __builtin_amdgcn_mfma_f32_32x32x16_bf16(a0, qf[s], s == 0 ? z16 : S0, 0, 0, 0);
        S1 = __builtin_amdgcn_mfma_f32_32x32x16_bf16(a1, qf[s], s == 0 ? z16 : S1, 0, 0, 0);
    }
    __builtin_amdgcn_s_setprio(0);
}
template <int DK, int DV, int MODE, int PASS, bool FULL>
DI void tile_smpv(LAS unsigned char* lds, LAS unsigned char* kb, const AttnIn& in, int j, f32x16& S0, f32x16& S1, f32x16 (&O)[DV / 32], float& m, float& l, float inv_l) {
    const int lane = threadIdx.x & 63, h = lane >> 5;
    const int key0 = j * 64;
    const unsigned long long selw = (j < 64) ? in.sel_lo : in.sel_hi;
    const bool rowsel = (MODE == 3) ? ((selw >> (j & 63)) & 1ull) : true;
    if (FULL && PASS == 0) {
        float mx = fmaxf(S0[0], S1[0]);
#pragma unroll
        for (int i = 1; i < 16; ++i) mx = fmaxf(mx, fmaxf(S0[i], S1[i]));
        const float rb = (MODE == 3 && !rowsel) ? -1e30f : 0.f;
        mx = mx * in.sc + rb;
        mx = fmaxf(mx, __shfl_xor(mx, 32));
        if (__any(mx - m > 8.0f)) {
            const float mn = fmaxf(m, mx);
            const float alpha = ex2(m - mn);
            m = mn;
            l *= alpha;
#pragma unroll
            for (int d = 0; d < DV / 32; ++d) O[d] *= alpha;
        }
        const float off = rb - m;
        float ls = 0.f;
#pragma unroll
        for (int i = 0; i < 16; ++i) { const float p0 = ex2(__builtin_fmaf(S0[i], in.sc, off)), p1 = ex2(__builtin_fmaf(S1[i], in.sc, off)); S0[i] = p0; S1[i] = p1; ls += p0 + p1; }
        l += ls;
        tile_pv<DK, DV>(kb, S0, S1, O);
        return;
    }
    int thr = 63, lo = 0;
    if (MODE == 0 || MODE == 3) thr = in.t - key0 - 4 * h;
    if (MODE == 1) { thr = in.t - key0 - 4 * h; lo = thr - 511; }
    if (MODE == 2) thr = ((in.t - 31) >> 4) - key0 - 4 * h;
    if (MODE == 3 && !rowsel) thr = -1;
#define VOK(c) (FULL || (MODE == 4) || (((c) <= thr) && (MODE != 1 || (c) >= lo)))
    if (PASS != 2) {
        float mx = -1e30f;
#pragma unroll
        for (int i = 0; i < 16; ++i) { const int c = 8 * (i >> 2) + (i & 3); S0[i] *= in.sc; S1[i] *= in.sc;
            mx = fmaxf(mx, VOK(c) ? S0[i] : -1e30f); mx = fmaxf(mx, VOK(c + 32) ? S1[i] : -1e30f); }
        mx = fmaxf(mx, __shfl_xor(mx, 32));
        const float mn = fmaxf(m, mx);
        const float alpha = ex2(m - mn);
        m = mn;
        float ls = 0.f;
#pragma unroll
        for (int i = 0; i < 16; ++i) { const int c = 8 * (i >> 2) + (i & 3);
            const float p0 = VOK(c) ? ex2(S0[i] - mn) : 0.f; const float p1 = VOK(c + 32) ? ex2(S1[i] - mn) : 0.f;
            S0[i] = p0; S1[i] = p1; ls += p0 + p1; }
        l = l * alpha + ls;
        if (PASS == 0) {
#pragma unroll
            for (int d = 0; d < DV / 32; ++d) O[d] *= alpha;
        }
    } else {
#pragma unroll
        for (int i = 0; i < 16; ++i) { const int c = 8 * (i >> 2) + (i & 3);
            const float p0 = VOK(c) ? ex2(S0[i] * in.sc - m) * inv_l : 0.f; const float p1 = VOK(c + 32) ? ex2(S1[i] * in.sc - m) * inv_l : 0.f;
            S0[i] = p0; S1[i] = p1; }
#undef VOK
        LAS unsigned* imp = (LAS unsigned*)(lds + LDS_IMP) + in.tt * IMPS;
#pragma unroll
        for (int kb2 = 0; kb2 < 2; ++kb2)
#pragma unroll
            for (int g4 = 0; g4 < 4; ++g4) {
                const float e0 = kb2 ? S1[4 * g4] : S0[4 * g4], e1 = kb2 ? S1[4 * g4 + 1] : S0[4 * g4 + 1], e2 = kb2 ? S1[4 * g4 + 2] : S0[4 * g4 + 2], e3 = kb2 ? S1[4 * g4 + 3] : S0[4 * g4 + 3];
                const int js = (key0 >> 2) + 8 * kb2 + 2 * g4 + h;
                const unsigned wm = (unsigned)((e0 + e1 + e2 + 0.5f * e3) * 536870912.f + 0.5f);
                const unsigned wh = (unsigned)(0.5f * e3 * 536870912.f + 0.5f);
                if (wm != 0u) __hip_atomic_fetch_add(imp + js, wm, __ATOMIC_RELAXED, __HIP_MEMORY_SCOPE_WORKGROUP);
                if (wh != 0u && js + 1 < 128) __hip_atomic_fetch_add(imp + js + 1, wh, __ATOMIC_RELAXED, __HIP_MEMORY_SCOPE_WORKGROUP);
            }
    }
    if (PASS != 1) tile_pv<DK, DV>(kb, S0, S1, O);
}

DI void lds_barrier() { asm volatile("s_waitcnt lgkmcnt(0)" ::: "memory"); __builtin_amdgcn_s_barrier(); asm volatile("" ::: "memory"); }
template <int MODE> DI void tile_flags(const AttnIn& in, int j, bool& wave_on, bool& full) {
    const int key0 = j * 64;
    wave_on = true; full = false;
    if (MODE == 0 || MODE == 3) { wave_on = key0 <= in.tw_hi; full = key0 + 63 <= in.tw_lo; }
    if (MODE == 3) wave_on = wave_on && ((((j < 64) ? in.wsel_lo : in.wsel_hi) >> (j & 63)) & 1ull);
    if (MODE == 1) { wave_on = (key0 <= in.tw_hi) && (key0 + 63 >= in.tw_lo - 511); full = (key0 + 63 <= in.tw_lo) && (key0 >= in.tw_hi - 511); }
    if (MODE == 2) { wave_on = 16 * key0 + 31 <= in.tw_hi; full = 16 * (key0 + 63) + 31 <= in.tw_lo; }
    if (MODE == 4) full = true;
}
template <int DK, int DV, int MODE, int PASS>
DI void smpv_dispatch(LAS unsigned char* lds, LAS unsigned char* kb, const AttnIn& in, int j, f32x16& S0, f32x16& S1, f32x16 (&O)[DV / 32], float& m, float& l, float inv_l) {
    bool wave_on, full; tile_flags<MODE>(in, j, wave_on, full);
    if (!wave_on) return;
    if (PASS == 0 && full) tile_smpv<DK, DV, MODE, PASS, true>(lds, kb, in, j, S0, S1, O, m, l, inv_l);
    else tile_smpv<DK, DV, MODE, PASS, false>(lds, kb, in, j, S0, S1, O, m, l, inv_l);
}
template <int DK, int DV, int MODE, int PASS>
DI void attn_stream(LAS unsigned char* lds, const AttnIn& in, const bf16x8 (&qf)[DK / 16], f32x16 (&O)[DV / 32], float& m, float& l) {
    using L = ALay<DK, DV>;
    static_assert(2 * L::BUF <= LDS_IMP, "tile buffers");
    u32x4 kr[L::KI], vr[L::VI];
    int j = in.jlo;
    LAS const unsigned* uni = (LAS const unsigned*)(lds + LDS_UNI);
    auto tile_on = [&](int jj) -> bool { if (MODE == 3) return (uni[jj >> 5] >> (jj & 31)) & 1u; return true; };
    while (j <= in.jhi && !tile_on(j)) ++j;
    if (j > in.jhi) return;
    const float inv_l = (PASS == 2) ? 1.f / fmaxf(l, 1e-30f) : 0.f;
    tile_load<DK, DV>(in.K + (size_t)j * 64 * in.kstride, in.kstride, in.V + (size_t)j * 64 * in.vstride, in.vstride, kr, vr);
    tile_store<DK, DV>(lds, kr, vr);
    __syncthreads();
    int cur = 0;
    f32x16 S0, S1;
    for (;;) {
        int jn = j + 1;
        while (jn <= in.jhi && !tile_on(jn)) ++jn;
        const bool has_next = jn <= in.jhi;
        if (has_next) tile_load<DK, DV>(in.K + (size_t)jn * 64 * in.kstride, in.kstride, in.V + (size_t)jn * 64 * in.vstride, in.vstride, kr, vr);
        LAS unsigned char* kb = lds + cur * L::BUF;
        bool wave_on, full; tile_flags<MODE>(in, j, wave_on, full);
        if (wave_on) {
            tile_qk<DK, DV>(kb, qf, S0, S1);
            if ((PASS == 0 || MODE == 2) && full) tile_smpv<DK, DV, MODE, PASS, true>(lds, kb, in, j, S0, S1, O, m, l, inv_l);
            else tile_smpv<DK, DV, MODE, PASS, false>(lds, kb, in, j, S0, S1, O, m, l, inv_l);
        }
        if (has_next) tile_store<DK, DV>(lds + (cur ^ 1) * L::BUF, kr, vr);
        lds_barrier();
        if (!has_next) break;
        j = jn; cur ^= 1;
    }
}

template <int DK> DI void load_q(const bf16_t* q, bf16x8 (&qf)[DK / 16]) {
    const int h = (threadIdx.x & 63) >> 5;
#pragma unroll
    for (int s = 0; s < DK / 16; ++s) qf[s] = *(const bf16x8*)(q + 16 * s + 8 * h);
}
template <int NV> DI void zeroO(f32x16 (&O)[NV]) {
#pragma unroll
    for (int d = 0; d < NV; ++d)
#pragma unroll
        for (int i = 0; i < 16; ++i) O[d][i] = 0.f;
}

template <int DK, int DV, int MODE>
DI void attn_mha_item(LAS unsigned char* lds, const bf16_t* Q, int qstride, const bf16_t* K, int kstride, const bf16_t* V, int vstride, bf16_t* Out, int ostride, int t0, int jhi, float sc) {
    const int wid = threadIdx.x >> 6, lane = threadIdx.x & 63, r = lane & 31, h = lane >> 5;
    AttnIn in; in.t = t0 + 32 * wid + r; in.tw_lo = t0 + 32 * wid; in.tw_hi = in.tw_lo + 31;
    in.q = Q + (size_t)in.t * qstride; in.K = K; in.V = V; in.kstride = kstride; in.vstride = vstride; in.jlo = 0; in.jhi = jhi; in.sc = sc;
    in.sel_lo = in.sel_hi = 0ull; in.wsel_lo = in.wsel_hi = ~0ull; in.tt = 0;
    bf16x8 qf[DK / 16]; load_q<DK>(in.q, qf);
    f32x16 O[DV / 32]; zeroO(O);
    float m = -1e30f, l = 0.f;
    attn_stream<DK, DV, MODE, 0>(lds, in, qf, O, m, l);
    l += __shfl_xor(l, 32);
    const float inv = 1.f / fmaxf(l, 1e-30f);
    bf16_t* o = Out + (size_t)in.t * ostride;
#pragma unroll
    for (int d = 0; d < DV / 32; ++d)
#pragma unroll
        for (int g4 = 0; g4 < 4; ++g4) { u32x2 w; w.x = pk2(O[d][4 * g4] * inv, O[d][4 * g4 + 1] * inv); w.y = pk2(O[d][4 * g4 + 2] * inv, O[d][4 * g4 + 3] * inv);
            *(u32x2*)(o + d * 32 + 8 * g4 + 4 * h) = w; }
}

template <int BR>
DI void nsa_item(LAS unsigned char* lds, const Params& p, int b, int g, int qt) {
    unsigned char* ws = p.ws;
    const int wid = threadIdx.x >> 6, lane = threadIdx.x & 63, r = lane & 31, h = lane >> 5;
    const int head = (BR == 3) ? 4 * g + (r >> 3) : 4 * g + (wid >> 1), t0 = qt * 64;
    AttnIn in;
    if (BR == 3) { in.tt = 8 * wid + (r & 7); in.tw_lo = t0 + 8 * wid; in.tw_hi = in.tw_lo + 7; }
    else { in.tt = 32 * (wid & 1) + r; in.tw_lo = t0 + 32 * (wid & 1); in.tw_hi = in.tw_lo + 31; }
    in.t = t0 + in.tt; in.wsel_lo = in.wsel_hi = ~0ull;
    const size_t tok = (size_t)b * SEQ + in.t;
    in.q = (const bf16_t*)(ws + O_QA) + (tok * 16 + head) * 96;
    in.sc = 0.10206207261596577f * 1.4426950408889634f;
    in.sel_lo = in.sel_hi = 0ull;
    const float* gnp = (const float*)(ws + O_GN) + tok * 48 + head * 3;
    bf16_t* oacc = (bf16_t*)(ws + O_OACC) + tok * 1024 + head * 64;
    bf16x8 qf[6]; load_q<96>(in.q, qf);
    f32x16 O[2]; zeroO(O);
    float m = -1e30f, l = 0.f;
    if (BR == 1) {
        in.K = (const bf16_t*)(ws + O_KW) + ((size_t)b * SEQ * 4 + g) * 96; in.kstride = 384;
        in.V = (const bf16_t*)(ws + O_VW) + ((size_t)b * SEQ * 4 + g) * 64; in.vstride = 256;
        in.jlo = qt >= 8 ? qt - 8 : 0; in.jhi = qt;
        attn_stream<96, 64, 1, 0>(lds, in, qf, O, m, l);
        l += __shfl_xor(l, 32);
        const float sc = gnp[2] / fmaxf(l, 1e-30f);
#pragma unroll
        for (int d = 0; d < 2; ++d)
#pragma unroll
            for (int g4 = 0; g4 < 4; ++g4) { u32x2 w; w.x = pk2(O[d][4 * g4] * sc, O[d][4 * g4 + 1] * sc); w.y = pk2(O[d][4 * g4 + 2] * sc, O[d][4 * g4 + 3] * sc); *(u32x2*)(oacc + d * 32 + 8 * g4 + 4 * h) = w; }
    }
    if (BR == 2) {
#ifdef DBG_KW
        in.K = (const bf16_t*)(ws + O_KCC) + ((size_t)b * 512 * 4 + g) * 96; in.kstride = 384;
        in.V = (const bf16_t*)(ws + O_VW) + ((size_t)b * SEQ * 4 + g) * 64; in.vstride = 256;
#else
        in.K = (const bf16_t*)(ws + O_KCC) + ((size_t)b * 512 * 4 + g) * 96; in.kstride = 384;
        in.V = (const bf16_t*)(ws + O_VCC) + ((size_t)b * 512 * 4 + g) * 64; in.vstride = 256;
#endif
        in.jlo = 0; in.jhi = ((t0 + 32) >> 4) >> 6;
        LAS unsigned* imp = (LAS unsigned*)(lds + LDS_IMP);
        for (int i = threadIdx.x; i < 64 * IMPS; i += NTHREADS) imp[i] = 0u;
        attn_stream<96, 64, 2, 1>(lds, in, qf, O, m, l);
        l += __shfl_xor(l, 32);
        zeroO(O);
        attn_stream<96, 64, 2, 2>(lds, in, qf, O, m, l);
        const float sc = gnp[0];
#pragma unroll
        for (int d = 0; d < 2; ++d)
#pragma unroll
            for (int g4 = 0; g4 < 4; ++g4) { u32x2* dp = (u32x2*)(oacc + d * 32 + 8 * g4 + 4 * h); const u32x2 hw = *dp;
                u32x2 w; w.x = pk2(bf2f(hw.x & 0xffffu) + O[d][4 * g4] * sc, bf2f(hw.x >> 16) + O[d][4 * g4 + 1] * sc); w.y = pk2(bf2f(hw.y & 0xffffu) + O[d][4 * g4 + 2] * sc, bf2f(hw.y >> 16) + O[d][4 * g4 + 3] * sc); *dp = w; }
#ifndef DBG_NO_IMP
        const int cur = qt;
        u32x4* selp = (u32x4*)(ws + O_SEL);
#pragma unroll 1
        for (int rr = 0; rr < 8; ++rr) {
            const int tt = wid * 8 + rr;
            LAS const unsigned* row = imp + tt * IMPS;
            unsigned long long blo, bhi;
            if (cur < 16) { blo = __ballot(lane <= cur); bhi = 0ull; }
            else {
                const int ja = lane, jb = lane + 64;
                const bool fa = (ja == 0) || (ja == cur) || (ja == cur - 1), fb = (jb == cur) || (jb == cur - 1);
                const unsigned xa = (ja <= cur) ? (fa ? 0xffffffffu : row[ja] + 1u) : 0u, xb = (jb <= cur) ? (fb ? 0xffffffffu : row[jb] + 1u) : 0u;
                unsigned Tk = 0u;
#pragma unroll 1
                for (int bit = 31; bit >= 0; --bit) { const unsigned c = Tk | (1u << bit);
                    const int cnt = __popcll(__ballot(xa >= c)) + __popcll(__ballot(xb >= c)); if (cnt >= 16) Tk = c; }
                const int ngt = __popcll(__ballot(xa > Tk)) + __popcll(__ballot(xb > Tk));
                const int need = 16 - ngt;
                const unsigned long long ta = __ballot(xa == Tk), tb = __ballot(xb == Tk), lt = (1ull << lane) - 1ull;
                const int pa = __popcll(ta & lt), pb = __popcll(ta) + __popcll(tb & lt);
                blo = __ballot(xa > Tk || (xa == Tk && pa < need)); bhi = __ballot(xb > Tk || (xb == Tk && pb < need));
            }
            if (lane == 0) { u32x4 w; w.x = (unsigned)blo; w.y = (unsigned)(blo >> 32); w.z = (unsigned)bhi; w.w = (unsigned)(bhi >> 32);
                selp[((size_t)b * SEQ + t0 + tt) * 4 + g] = w; }
        }
#endif
        __syncthreads();
    }
    if (BR == 3) {
        in.K = (const bf16_t*)(ws + O_KS) + ((size_t)b * SEQ * 4 + g) * 96; in.kstride = 384;
        in.V = (const bf16_t*)(ws + O_VS) + ((size_t)b * SEQ * 4 + g) * 64; in.vstride = 256;
        in.jlo = 0; in.jhi = qt;
        const u32x4 sw = ((const u32x4*)(ws + O_SEL))[tok * 4 + g];
        in.sel_lo = (unsigned long long)sw.x | ((unsigned long long)sw.y << 32); in.sel_hi = (unsigned long long)sw.z | ((unsigned long long)sw.w << 32);
        LAS unsigned* uni = (LAS unsigned*)(lds + LDS_UNI);
        if (threadIdx.x < 4) uni[threadIdx.x] = 0u;
        __syncthreads();
        { unsigned long long wl = in.sel_lo, wh = in.sel_hi;
#pragma unroll
          for (int o = 1; o < 8; o <<= 1) { wl |= __shfl_xor(wl, o); wh |= __shfl_xor(wh, o); }
          in.wsel_lo = __builtin_amdgcn_readfirstlane((unsigned)wl) | ((unsigned long long)__builtin_amdgcn_readfirstlane((unsigned)(wl >> 32)) << 32);
          in.wsel_hi = __builtin_amdgcn_readfirstlane((unsigned)wh) | ((unsigned long long)__builtin_amdgcn_readfirstlane((unsigned)(wh >> 32)) << 32); }
        if ((r >> 3) == 0) {
            __hip_atomic_fetch_or(uni + 0, sw.x, __ATOMIC_RELAXED, __HIP_MEMORY_SCOPE_WORKGROUP); __hip_atomic_fetch_or(uni + 1, sw.y, __ATOMIC_RELAXED, __HIP_MEMORY_SCOPE_WORKGROUP);
            __hip_atomic_fetch_or(uni + 2, sw.z, __ATOMIC_RELAXED, __HIP_MEMORY_SCOPE_WORKGROUP); __hip_atomic_fetch_or(uni + 3, sw.w, __ATOMIC_RELAXED, __HIP_MEMORY_SCOPE_WORKGROUP);
        }
        __syncthreads();
#ifndef DBG_SEL_SKIP
        attn_stream<96, 64, 3, 0>(lds, in, qf, O, m, l);
#endif
        l += __shfl_xor(l, 32);
        const float sc = gnp[1] / fmaxf(l, 1e-30f);
        bf16_t* oa = (bf16_t*)(ws + O_OA) + tok * 1024 + head * 64;
#pragma unroll
        for (int d = 0; d < 2; ++d)
#pragma unroll
            for (int g4 = 0; g4 < 4; ++g4) { const u32x2 hw = *(const u32x2*)(oacc + d * 32 + 8 * g4 + 4 * h);
                u32x2 w; w.x = pk2(bf2f(hw.x & 0xffffu) + O[d][4 * g4] * sc, bf2f(hw.x >> 16) + O[d][4 * g4 + 1] * sc); w.y = pk2(bf2f(hw.y & 0xffffu) + O[d][4 * g4 + 2] * sc, bf2f(hw.y >> 16) + O[d][4 * g4 + 3] * sc);
                *(u32x2*)(oa + d * 32 + 8 * g4 + 4 * h) = w; }
    }
}

DI int snake_rank(int i) { const int G = gridDim.x, b = blockIdx.x; return i * G + ((i & 1) ? (G - 1 - b) : b); }


#define XB_TMO      128
#define XB_XCNT(j)  (256  + 64 * (j))
#define XB_XSUB(j)  (1280 + 64 * (j))
#define XB_XGEN(j)  (2304 + 64 * (j))
#define XB_TOP      3328
#define XB_TOPGEN   3392
#define XB_SPIN_CAP (1u << 18)
DI unsigned xb_ld(unsigned* p)              { return __hip_atomic_load(p, __ATOMIC_RELAXED, __HIP_MEMORY_SCOPE_AGENT); }
DI unsigned xb_add(unsigned* p, unsigned v) { return __hip_atomic_fetch_add(p, v, __ATOMIC_RELAXED, __HIP_MEMORY_SCOPE_AGENT); }
DI unsigned xb_xcc_id() { return (unsigned)__builtin_amdgcn_s_getreg((3 << 11) | 20) & 0xFu; }
#define XB_SPIN(cond, bar) do { unsigned _sp = 0; while (cond) { __builtin_amdgcn_s_sleep(1); \
    if ((++_sp & 255u) == 0u) { if (xb_ld(&(bar)[XB_TMO])) break; if (_sp > XB_SPIN_CAP) { atomicAdd(&(bar)[XB_TMO], 1u); break; } } } } while (0)
struct XcdBarrier { unsigned* bar; unsigned x; volatile LAS unsigned* st; };
DI XcdBarrier xcd_barrier_post(unsigned* bar, volatile LAS unsigned* st) {
    XcdBarrier b; b.bar = bar; b.x = xb_xcc_id(); b.st = st;
    if (threadIdx.x == 0) (void)xb_add(&bar[XB_XCNT(b.x)], 1u);
    return b;
}
DI void xcd_barrier_complete(unsigned* bar, unsigned x, unsigned& nloc, unsigned& nx) {
    const unsigned G = gridDim.x * gridDim.y * gridDim.z;
    unsigned sum, cnt, mine, sp = 0u;
    for (;;) {
        sum = 0u; cnt = 0u; mine = 0u;
#pragma unroll
        for (unsigned j = 0; j < 16; ++j) { const unsigned c = xb_ld(&bar[XB_XCNT(j)]); sum += c; cnt += (c > 0u) ? 1u : 0u; mine = (j == x) ? c : mine; }
        if (sum == G) break;
        __builtin_amdgcn_s_sleep(1);
        if ((++sp & 255u) == 0u) { if (xb_ld(&bar[XB_TMO])) break; if (sp > XB_SPIN_CAP) { atomicAdd(&bar[XB_TMO], 1u); break; } }
    }
    nloc = mine > 0u ? mine : 1u; nx = cnt > 0u ? cnt : 1u;
}
DI void xcd_barrier(const XcdBarrier& b) {
    asm volatile("s_waitcnt vmcnt(0)" ::: "memory");
    __syncthreads();
    if (threadIdx.x == 0) {
        unsigned* bar = b.bar;
        __builtin_amdgcn_s_waitcnt(0);
        unsigned nloc = b.st[0], nx = b.st[1];
        if (nloc == 0u) { xcd_barrier_complete(bar, b.x, nloc, nx); b.st[0] = nloc; b.st[1] = nx; }
        const unsigned old = xb_add(&bar[XB_XSUB(b.x)], 1u);
        const unsigned gen = old / nloc;
        if (old + 1u == (gen + 1u) * nloc) {
            __builtin_amdgcn_fence(__ATOMIC_RELEASE, "agent");
            asm volatile("s_waitcnt vmcnt(0)" ::: "memory");
            const unsigned og = xb_add(&bar[XB_TOP], 1u);
            const unsigned tg = og / nx;
            if (og + 1u == (tg + 1u) * nx) xb_add(&bar[XB_TOPGEN], 1u);
            else XB_SPIN(xb_ld(&bar[XB_TOPGEN]) == tg, bar);
            __builtin_amdgcn_fence(__ATOMIC_ACQUIRE, "agent");
            xb_add(&bar[XB_XGEN(b.x)], 1u);
            asm volatile("s_waitcnt vmcnt(0)" ::: "memory");
        } else {
            XB_SPIN(xb_ld(&bar[XB_XGEN(b.x)]) == gen, bar);
            __builtin_amdgcn_fence(__ATOMIC_ACQUIRE, "agent");
            asm volatile("s_waitcnt vmcnt(0)" ::: "memory");
        }
    }
    __syncthreads();
}

#ifndef PHMASK
#define PHMASK 0xFFFF
#endif
#define PHON(n) ((PHMASK >> (n)) & 1)
__global__ void __launch_bounds__(NTHREADS, 2) fwd_megakernel(Params p_arg) {
    const Params& p = *(const Params*)__builtin_amdgcn_kernarg_segment_ptr();
    extern __shared__ __attribute__((aligned(16))) unsigned char smem[];
    LAS unsigned char* lds = (LAS unsigned char*)smem;
    cg::grid_group grid = cg::this_grid();
    __shared__ uint4 xb_words;
    if (threadIdx.x == 0) xb_words = make_uint4(0u, 0u, 0u, 0u);
    __syncthreads();
    const XcdBarrier xb = xcd_barrier_post((unsigned*)(p_arg.ws + O_BAR), (volatile LAS unsigned*)&xb_words);
    unsigned char* ws = p.ws;
    const int gwave = blockIdx.x * (NTHREADS / 64) + (threadIdx.x >> 6), nwave = gridDim.x * (NTHREADS / 64);
    float* ssq = (float*)(ws + O_SSQ);
    if (PHON(0) && p.ph_lo <= 0 && 0 < p.ph_hi) { phase_prep(p, lds); }
    if (PHON(1) && p.ph_lo <= 1 && 1 < p.ph_hi) { if (1 > p.ph_lo) grid.sync();
            FGemm1 f{ws, 256};
            run_gemm(lds, (const bf16_t*)(ws + O_XN), (const bf16_t*)(ws + O_WIN) + (size_t)256 * 2048, T, 4096, 2048, f, 0);
            FMemKV fm{(bf16_t*)(ws + O_KMEM), (bf16_t*)(ws + O_VMEM)};
            run_gemm(lds, (const bf16_t*)(ws + O_MEMN), (const bf16_t*)(ws + O_WXKV), BATCH * MEM, 1024, 2048, fm, 128);
    }
    if (PHON(2) && p.ph_lo <= 2 && 2 < p.ph_hi) { if (2 > p.ph_lo) xcd_barrier(xb);
#ifndef P2SEL
#define P2SEL 7
#endif
            { FGemm1 f0{ws, 0}; run_gemm(lds, (const bf16_t*)(ws + O_XN), (const bf16_t*)(ws + O_WIN), T, 256, 2048, f0, 128); }
            if (P2SEL & 1) { FUq fq{ws}; run_gemm(lds, (const bf16_t*)(ws + O_CQ), (const bf16_t*)(ws + O_WUQ), T, 1536, 512, fq, 0); }
            if (P2SEL & 2) { FUkv fk{ws}; run_gemm(lds, (const bf16_t*)(ws + O_CKV), (const bf16_t*)(ws + O_WUK), T, 2048, 256, fk, 0); }
#ifndef NO_CMP1
            for (int wt = gwave; wt < 1024; wt += nwave) {
                if (wt < 512) compress_stage1<96>((const bf16_t*)(ws + O_KC), (const bf16_t*)(ws + O_W1K), (const float*)(ws + O_BIASK), (bf16_t*)(ws + O_HK), wt);
                else compress_stage1<64>((const bf16_t*)(ws + O_VC), (const bf16_t*)(ws + O_W1V), (const float*)(ws + O_BIASK) + 96, (bf16_t*)(ws + O_HV), wt - 512);
            }
#endif
    }
    if (PHON(3) && p.ph_lo <= 3 && 3 < p.ph_hi) { if (3 > p.ph_lo) xcd_barrier(xb);
            for (int wt = gwave; wt < 1024; wt += nwave) {
                if (wt < 512) compress_stage2<96>((const bf16_t*)(ws + O_HK), (const bf16_t*)(ws + O_W2K), (bf16_t*)(ws + O_KCC), wt);
                else compress_stage2<64>((const bf16_t*)(ws + O_HV), (const bf16_t*)(ws + O_W2V), (bf16_t*)(ws + O_VCC), wt - 512);
            }
            for (int i = 0;; ++i) { const int rk = snake_rank(i); if (rk >= 2048) break;
                const int qt = 31 - (rk >> 6), bh = rk & 63, b = bh >> 4, hd = bh & 15;
                attn_mha_item<96, 64, 0>(lds, (const bf16_t*)(ws + O_QMLA) + ((size_t)b * SEQ * 16 + hd) * 96, 1536, (const bf16_t*)(ws + O_KMLA) + ((size_t)b * SEQ * 16 + hd) * 96, 1536,
                                         (const bf16_t*)(ws + O_VMLA) + ((size_t)b * SEQ * 16 + hd) * 64, 1024, (bf16_t*)(ws + O_OB) + (size_t)b * SEQ * 1024 + hd * 64, 1024, qt * 256, qt * 4 + 3,
                                         0.10206207261596577f * 1.4426950408889634f); }
#ifndef DBG_NO_NSA
            for (int it = blockIdx.x; it < 2048; it += gridDim.x) { const int qt = it >> 4, bg = it & 15; nsa_item<1>(lds, p, bg >> 2, bg & 3, qt); }
#endif
    }
#ifdef DBG_PROBE
    { grid.sync();
      if (blockIdx.x == 0) {
          unsigned code = 0;
          const bf16_t* bufs[5] = {(const bf16_t*)(ws + O_KC), (const bf16_t*)(ws + O_W1K), (const bf16_t*)(ws + O_HK), (const bf16_t*)(ws + O_W2K), (const bf16_t*)(ws + O_KCC)};
          const int lens[5] = {4 * 1024 * 1024, 96 * 3072, 8192 * 96, 96 * 96, 8192 * 96};
          const int bits[5] = {1, 2, 8, 16, 32};
          LAS unsigned* red = (LAS unsigned*)lds;
          if (threadIdx.x == 0) red[0] = 0u;
          __syncthreads();
          for (int q = 0; q < 5; ++q) { unsigned bad = 0; for (int i = threadIdx.x; i < lens[q]; i += NTHREADS) { if ((bufs[q][i] & 0x7f80u) == 0x7f80u) bad = 1; }
              if (bad) __hip_atomic_fetch_or(red, (unsigned)bits[q], __ATOMIC_RELAXED, __HIP_MEMORY_SCOPE_WORKGROUP); }
          if (threadIdx.x < 160) { const unsigned u = __float_as_uint(((const float*)(ws + O_BIASK))[threadIdx.x]); if ((u & 0x7f800000u) == 0x7f800000u) __hip_atomic_fetch_or(red, 4u, __ATOMIC_RELAXED, __HIP_MEMORY_SCOPE_WORKGROUP); }
          __syncthreads();
          if (threadIdx.x == 0) ((float*)(ws + O_BIASK))[200] = (float)((10 + red[0]) * 100);
          __syncthreads();
      }
    }
#endif
    if (PHON(4) && p.ph_lo <= 4 && 4 < p.ph_hi) { if (4 > p.ph_lo) xcd_barrier(xb);
            for (int i = 0;; ++i) { const int rk = snake_rank(i); if (rk >= 2048) break; const int qt = 127 - (rk >> 4), bg = rk & 15; nsa_item<2>(lds, p, bg >> 2, bg & 3, qt); }
    }
    if (PHON(5) && p.ph_lo <= 5 && 5 < p.ph_hi) { if (5 > p.ph_lo) xcd_barrier(xb);
#ifndef NO_SEL
            for (int i = 0;; ++i) { const int rk = snake_rank(i); if (rk >= 2048) break; const int qt = 127 - (rk >> 4), bg = rk & 15; nsa_item<3>(lds, p, bg >> 2, bg & 3, qt); }
#endif
#ifndef NO_GATE
            FGate fg{(bf16_t*)(ws + O_GATES)};
            run_gemm(lds, (const bf16_t*)(ws + O_XN), (const bf16_t*)(ws + O_WG), T, 4096, 2048, fg, 0);
#endif
    }
    if (PHON(6) && p.ph_lo <= 6 && 6 < p.ph_hi) { if (6 > p.ph_lo) xcd_barrier(xb);
#ifndef DBG_NO_NSA
            FMix<0> fa{(const bf16_t*)(ws + O_GATES), (bf16_t*)(ws + O_MIXED)};
            run_gemm(lds, (const bf16_t*)(ws + O_OA), (const bf16_t*)(ws + O_WONA), T, 2048, 1024, fa, 0);
#endif
            FMix<1> fb{(const bf16_t*)(ws + O_GATES), (bf16_t*)(ws + O_MIXED)};
            run_gemm(lds, (const bf16_t*)(ws + O_OB), (const bf16_t*)(ws + O_WONB), T, 2048, 1024, fb, 0);
    }
    if (PHON(7) && p.ph_lo <= 7 && 7 < p.ph_hi) { if (7 > p.ph_lo) xcd_barrier(xb);
            FResid<0> f{p.x, p.out, (bf16_t*)(ws + O_XN), ssq + 2 * T};
            run_gemm(lds, (const bf16_t*)(ws + O_MIXED), (const bf16_t*)(ws + O_WOUT), T, 2048, 2048, f, 0);
    }
#if defined(DBG_COPY) && DBG_COPY == 2
    { grid.sync();
      const int lane = threadIdx.x & 63;
      for (int row = gwave; row < T; row += nwave) {
          float ss = 0.f;
#pragma unroll
          for (int i = 0; i < 8; ++i) { const size_t o = (size_t)row * 2048 + (i * 64 + lane) * 4; const f32x4 v = *(const f32x4*)(p.x + o); *(f32x4*)(p.out + o) = v;
              u32x2 w; w.x = pk2(v[0], v[1]); w.y = pk2(v[2], v[3]); *(u32x2*)((bf16_t*)(ws + O_XN) + o) = w; ss += v[0]*v[0] + v[1]*v[1] + v[2]*v[2] + v[3]*v[3]; }
          ss = wave_sum(ss);
          if (lane == 0) ssq[DBG_COPY * T + row] = ss;
      }
    }
#endif
    if (PHON(8) && p.ph_lo <= 8 && 8 < p.ph_hi) { if (8 > p.ph_lo) xcd_barrier(xb);
            FXq f{(bf16_t*)(ws + O_QX), ssq + 2 * T};
            run_gemm(lds, (const bf16_t*)(ws + O_XN), (const bf16_t*)(ws + O_WXQ), T, 512, 2048, f, 0);
    }
    if (PHON(9) && p.ph_lo <= 9 && 9 < p.ph_hi) { if (9 > p.ph_lo) xcd_barrier(xb);
            for (int it = blockIdx.x; it < 512; it += gridDim.x) { const int qt = it >> 4, bh = it & 15, b = bh >> 2, hd = bh & 3;
                attn_mha_item<128, 128, 4>(lds, (const bf16_t*)(ws + O_QX) + ((size_t)b * SEQ * 4 + hd) * 128, 512, (const bf16_t*)(ws + O_KMEM) + ((size_t)b * MEM * 4 + hd) * 128, 512,
                                           (const bf16_t*)(ws + O_VMEM) + ((size_t)b * MEM * 4 + hd) * 128, 512, (bf16_t*)(ws + O_OX) + (size_t)b * SEQ * 512 + hd * 128, 512, qt * 256, 3,
                                           0.08838834764831845f * 1.4426950408889634f); }
    }
    if (PHON(10) && p.ph_lo <= 10 && 10 < p.ph_hi) { if (10 > p.ph_lo) xcd_barrier(xb);
            FResid<1> f{nullptr, p.out, (bf16_t*)(ws + O_XN), ssq + 3 * T};
            run_gemm(lds, (const bf16_t*)(ws + O_OX), (const bf16_t*)(ws + O_WXO), T, 2048, 512, f, 0);
    }
#if defined(DBG_COPY) && DBG_COPY == 3
    { grid.sync();
      const int lane = threadIdx.x & 63;
      for (int row = gwave; row < T; row += nwave) {
          float ss = 0.f;
#pragma unroll
          for (int i = 0; i < 8; ++i) { const size_t o = (size_t)row * 2048 + (i * 64 + lane) * 4; const f32x4 v = *(const f32x4*)(p.x + o); *(f32x4*)(p.out + o) = v;
              u32x2 w; w.x = pk2(v[0], v[1]); w.y = pk2(v[2], v[3]); *(u32x2*)((bf16_t*)(ws + O_XN) + o) = w; ss += v[0]*v[0] + v[1]*v[1] + v[2]*v[2] + v[3]*v[3]; }
          ss = wave_sum(ss);
          if (lane == 0) ssq[DBG_COPY * T + row] = ss;
      }
    }
#endif
    if (PHON(11) && p.ph_lo <= 11 && 11 < p.ph_hi) { if (11 > p.ph_lo) xcd_barrier(xb);
            FFf1 f{(bf16_t*)(ws + O_U), ssq + 3 * T};
            run_gemm(lds, (const bf16_t*)(ws + O_XN), (const bf16_t*)(ws + O_WFF1), T, 8192, 2048, f, 0);
    }
    if (PHON(12) && p.ph_lo <= 12 && 12 < p.ph_hi) { if (12 > p.ph_lo) xcd_barrier(xb);
            FResid<1> f{nullptr, p.out, (bf16_t*)(ws + O_XN), ssq + 4 * T};
            run_gemm(lds, (const bf16_t*)(ws + O_U), (const bf16_t*)(ws + O_WFF2), T, 2048, 8192, f, 0);
    }
    if (PHON(13) && p.ph_lo <= 13 && 13 < p.ph_hi) { if (13 > p.ph_lo) xcd_barrier(xb);
            const int lane = threadIdx.x & 63;
            for (int row = gwave; row < T; row += nwave) {
                const float rs = rsqrtf(ssq[4 * T + row] * (1.f / 2048.f) + EPS);
#pragma unroll
                for (int i = 0; i < 4; ++i) { const int c0 = (i * 64 + lane) * 8; float* op = p.out + (size_t)row * 2048 + c0;
                    const u32x4 hw = *(const u32x4*)((const bf16_t*)(ws + O_XN) + (size_t)row * 2048 + c0);
                    f32x4 va, vb; unpack8(hw, va, vb);
                    const f32x4 g0 = *(const f32x4*)(p.g_final + c0), g1 = *(const f32x4*)(p.g_final + c0 + 4);
                    *(f32x4*)op = (f32x4){va[0] * rs * g0[0], va[1] * rs * g0[1], va[2] * rs * g0[2], va[3] * rs * g0[3]};
                    *(f32x4*)(op + 4) = (f32x4){vb[0] * rs * g1[0], vb[1] * rs * g1[1], vb[2] * rs * g1[2], vb[3] * rs * g1[3]}; }
            }
#ifdef DBG_PROBE
            grid.sync(); if (blockIdx.x == 0 && threadIdx.x == 0) p.out[0] = ((const float*)(ws + O_BIASK))[200];
#endif
    }
}

constexpr int NPHASES = 14;
#ifndef MK_MULTI
#define MK_MULTI 0
#endif

extern "C" void kernel_launch(void* const* d_in, const int* in_sizes, int n_in, void* d_out, int out_size, void* d_ws, size_t ws_size, hipStream_t stream) {
    static int grid = 0;
    if (grid == 0) {
        if (n_in != 27 || ws_size < O_END2) { fprintf(stderr, "kernel_launch: unexpected n_in %d / ws %zu (need %zu)\n", n_in, ws_size, (size_t)O_END2); grid = -1; return; }
        int dev = 0, cus = 0, per_cu = 0;
        hipGetDevice(&dev);
        hipDeviceGetAttribute(&cus, hipDeviceAttributeMultiprocessorCount, dev);
        if (hipFuncSetAttribute((const void*)fwd_megakernel, hipFuncAttributeMaxDynamicSharedMemorySize, LDS_BYTES) != hipSuccess) { fprintf(stderr, "kernel_launch: hipFuncSetAttribute failed\n"); grid = -1; return; }
        if (hipOccupancyMaxActiveBlocksPerMultiprocessor(&per_cu, (const void*)fwd_megakernel, NTHREADS, LDS_BYTES) != hipSuccess || per_cu < 1) { fprintf(stderr, "kernel_launch: occupancy query gave %d\n", per_cu); per_cu = 1; }
        (void)hipGetLastError();
        grid = cus * per_cu;
    }
    if (grid < 0) return;
    Params p{};
    const float** pp = (const float**)&p;
    for (int i = 0; i < 27; ++i) pp[i] = (const float*)d_in[i];
    p.out = (float*)d_out; p.ws = (unsigned char*)d_ws;
#if MK_MULTI
    for (int ph = 0; ph < NPHASES; ++ph) {
        p.ph_lo = ph; p.ph_hi = ph + 1;
        hipLaunchKernelGGL(fwd_megakernel, dim3(grid), dim3(NTHREADS), LDS_BYTES, stream, p);
    }
#else
    (void)hipMemsetAsync((char*)d_ws + O_BAR, 0, (size_t)XCD_BAR_WORDS * 4, stream);
    p.ph_lo = 0; p.ph_hi = NPHASES;
    void* args[] = {&p};
    hipError_t e = hipLaunchCooperativeKernel((const void*)fwd_megakernel, dim3(grid), dim3(NTHREADS), args, LDS_BYTES, stream);
    if (e != hipSuccess) fprintf(stderr, "cooperative launch failed: %s (grid %d)\n", hipGetErrorString(e), grid);
#endif
}
```

```cpp
#include <hip/hip_runtime.h>
#include <hip/hip_cooperative_groups.h>
#include <cstdio>
namespace cg = cooperative_groups;

#define LAS __attribute__((address_space(3)))
#define DI __device__ __forceinline__
typedef unsigned short bf16_t;
typedef short bf16x8 __attribute__((ext_vector_type(8)));
typedef short s16x4 __attribute__((ext_vector_type(4)));
typedef float f32x4 __attribute__((ext_vector_type(4)));
typedef float f32x16 __attribute__((ext_vector_type(16)));
typedef unsigned u32x4 __attribute__((ext_vector_type(4)));
typedef unsigned u32x2 __attribute__((ext_vector_type(2)));

constexpr int SEQ = 8192, BATCH = 4, T = BATCH * SEQ, DM = 2048, DFF = 8192, MEM = 256;
constexpr int DIN = 8400;
constexpr float EPS = 1e-6f;
constexpr int NTHREADS = 512;
constexpr int LDS_BYTES = 131072;

constexpr size_t al256(size_t x) { return (x + 255) & ~(size_t)255; }
constexpr size_t O_WIN = 0;
constexpr size_t O_WG = O_WIN + (size_t)4352 * 2048 * 2;
constexpr size_t O_WUQ = O_WG + (size_t)4096 * 2048 * 2;
constexpr size_t O_WUK = O_WUQ + (size_t)1536 * 512 * 2;
constexpr size_t O_WUV = O_WUK + (size_t)1024 * 256 * 2;
constexpr size_t O_W1K = O_WUV + (size_t)1024 * 256 * 2;
constexpr size_t O_W1V = O_W1K + (size_t)96 * 3072 * 2;
constexpr size_t O_W2K = O_W1V + (size_t)64 * 2048 * 2;
constexpr size_t O_W2V = al256(O_W2K + 96 * 96 * 2);
constexpr size_t O_WONA = al256(O_W2V + 64 * 64 * 2);
constexpr size_t O_WONB = O_WONA + (size_t)2048 * 1024 * 2;
constexpr size_t O_WOUT = O_WONB + (size_t)2048 * 1024 * 2;
constexpr size_t O_WXQ = O_WOUT + (size_t)2048 * 2048 * 2;
constexpr size_t O_WXKV = O_WXQ + (size_t)512 * 2048 * 2;
constexpr size_t O_WXO = O_WXKV + (size_t)1024 * 2048 * 2;
constexpr size_t O_WFF1 = O_WXO + (size_t)2048 * 512 * 2;
constexpr size_t O_WFF2 = O_WFF1 + (size_t)8192 * 2048 * 2;
constexpr size_t O_BIASK = O_WFF2 + (size_t)2048 * 8192 * 2;
constexpr size_t O_COSA = al256(O_BIASK + 1024);
constexpr size_t O_SINA = O_COSA + (size_t)SEQ * 12 * 4;
constexpr size_t O_COSB = O_SINA + (size_t)SEQ * 12 * 4;
constexpr size_t O_SINB = O_COSB + (size_t)SEQ * 16 * 4;
constexpr size_t O_SSQ = O_SINB + (size_t)SEQ * 16 * 4;
constexpr size_t O_MEMN = O_SSQ + (size_t)5 * T * 4;
constexpr size_t O_KMEM = O_MEMN + (size_t)1024 * 2048 * 2;
constexpr size_t O_VMEM = O_KMEM + (size_t)1024 * 512 * 2;
constexpr size_t O_KCC = O_VMEM + (size_t)1024 * 512 * 2;
constexpr size_t O_VCC = O_KCC + (size_t)4 * 512 * 4 * 96 * 2;
constexpr size_t O_HK = O_VCC + (size_t)4 * 512 * 4 * 64 * 2;
constexpr size_t O_HV = O_HK + (size_t)8192 * 96 * 2;
constexpr size_t O_SEL = O_HV + (size_t)8192 * 64 * 2;
constexpr size_t O_GN = O_SEL + (size_t)T * 4 * 16;
constexpr size_t O_XN = al256(O_GN + (size_t)T * 48 * 4);
constexpr size_t O_OACC = O_XN + (size_t)T * 2048 * 2;
constexpr size_t O_OB = O_OACC + (size_t)T * 1024 * 4;
constexpr size_t O_R = O_OB + (size_t)T * 1024 * 2;
constexpr size_t O_QA = O_R;
constexpr size_t O_KS = O_QA + (size_t)T * 1536 * 2;
constexpr size_t O_VS = O_KS + (size_t)T * 384 * 2;
constexpr size_t O_KC = O_VS + (size_t)T * 256 * 2;
constexpr size_t O_KW = O_KC + (size_t)T * 384 * 2;
constexpr size_t O_VC = O_KW + (size_t)T * 384 * 2;
constexpr size_t O_VW = O_VC + (size_t)T * 256 * 2;
constexpr size_t O_CQ = O_VW + (size_t)T * 256 * 2;
constexpr size_t O_CKV = O_CQ + (size_t)T * 512 * 2;
constexpr size_t O_QMLA = O_CKV + (size_t)T * 256 * 2;
constexpr size_t O_KMLA = O_QMLA + (size_t)T * 1536 * 2;
constexpr size_t O_VMLA = O_KMLA + (size_t)T * 1536 * 2;
constexpr size_t O_END = O_VMLA + (size_t)T * 1024 * 2;
constexpr size_t O_OA = O_KC;
constexpr size_t O_GATES = O_QMLA;
constexpr size_t O_MIXED = O_QA;
constexpr size_t O_QX = O_KC;
constexpr size_t O_OX = O_KC + (size_t)T * 512 * 2;
constexpr size_t O_U = O_R;
static_assert(O_GATES + (size_t)T * 4096 * 2 <= O_END, "gates alias");
static_assert(O_U + (size_t)T * 8192 * 2 <= O_END, "u alias");
constexpr size_t O_BAR = O_END;
constexpr int XCD_BAR_WORDS = 3456;
constexpr size_t O_END2 = O_BAR + (size_t)XCD_BAR_WORDS * 4;
static_assert(O_END2 <= (size_t)1073741824, "workspace");

struct Params {
    const float *x, *mem, *g_mix, *w_in, *cmp_pos_k, *cmp_w1_k, *cmp_w2_k, *cmp_pos_v, *cmp_w1_v, *cmp_w2_v,
        *mla_g_q, *mla_w_uq, *mla_g_kv, *mla_w_uk, *mla_w_uv, *w_o_nsa, *w_o_mla, *w_out, *g_xattn, *g_mem,
        *xa_wq, *xa_wkv, *xa_wo, *g_mlp, *w_ff1, *w_ff2, *g_final;
    float* out;
    unsigned char* ws;
    int ph_lo, ph_hi;
};

DI float bf2f(unsigned b) { return __uint_as_float(b << 16); }
typedef float f32x2_t __attribute__((ext_vector_type(2)));
typedef __bf16 bf16x2_t __attribute__((ext_vector_type(2)));
DI unsigned pk2(float lo, float hi) { const f32x2_t v = {lo, hi}; return __builtin_bit_cast(unsigned, __builtin_convertvector(v, bf16x2_t)); }
DI bf16_t f2bf(float f) { return (bf16_t)(pk2(f, 0.f) & 0xffffu); }
DI float ex2(float x) { return __builtin_amdgcn_exp2f(x); }
DI float sigm(float x) { return __builtin_amdgcn_rcpf(1.f + __builtin_amdgcn_exp2f(-1.4426950408889634f * x)); }
DI float wave_sum(float v) {
#pragma unroll
    for (int o = 32; o > 0; o >>= 1) v += __shfl_xor(v, o);
    return v;
}
DI int permNSA(int p) { return p < 24 ? ((p & 1) ? 12 + (p >> 1) : (p >> 1)) : p; }
DI int permMLA(int p) { return (p & 1) ? 16 + (p >> 1) : (p >> 1); }
DI u32x4 pack8(f32x4 a, f32x4 b) { u32x4 w; w.x = pk2(a[0], a[1]); w.y = pk2(a[2], a[3]); w.z = pk2(b[0], b[1]); w.w = pk2(b[2], b[3]); return w; }
DI void unpack8(u32x4 w, f32x4& a, f32x4& b) {
    a[0] = bf2f(w.x & 0xffffu); a[1] = bf2f(w.x >> 16); a[2] = bf2f(w.y & 0xffffu); a[3] = bf2f(w.y >> 16);
    b[0] = bf2f(w.z & 0xffffu); b[1] = bf2f(w.z >> 16); b[2] = bf2f(w.w & 0xffffu); b[3] = bf2f(w.w >> 16);
}
DI void rope8(f32x4& a, f32x4& b, f32x4 c, f32x4 s) {
    float o0 = a[0] * c[0] - a[1] * s[0], o1 = a[0] * s[0] + a[1] * c[0];
    float o2 = a[2] * c[1] - a[3] * s[1], o3 = a[2] * s[1] + a[3] * c[1];
    float o4 = b[0] * c[2] - b[1] * s[2], o5 = b[0] * s[2] + b[1] * c[2];
    float o6 = b[2] * c[3] - b[3] * s[3], o7 = b[2] * s[3] + b[3] * c[3];
    a[0] = o0; a[1] = o1; a[2] = o2; a[3] = o3; b[0] = o4; b[1] = o5; b[2] = o6; b[3] = o7;
}
DI float sumsq8(f32x4 a, f32x4 b) { return a[0]*a[0] + a[1]*a[1] + a[2]*a[2] + a[3]*a[3] + b[0]*b[0] + b[1]*b[1] + b[2]*b[2] + b[3]*b[3]; }

namespace pg8 {
constexpr int BM = 256, BK = 64, HALF = 128, HTB = HALF * BK * 2, STAGE_BYTES = 8 * HTB, NXCD = 8, WGM = 8;
DI int lds_byte(int r, int c) { const int st = (r >> 4) * 2 + (c >> 5), rr = r & 15, cc = c & 31, ob = rr * 64 + cc * 2; return st * 1024 + (ob ^ (((ob >> 9) & 1) << 5)); }
DI void stage_rc(int b, int& R, int& C) { const int st = b / 1024, sb = b % 1024, swz = sb ^ (((sb >> 9) & 1) << 5); R = (st >> 1) * 16 + swz / 64; C = (st & 1) * 32 + (swz % 64) / 2; }
DI int perm32(int rho) { const int n = rho >> 4, i = rho & 15; return 8 * (i >> 2) + 4 * n + (i & 3); }
struct Unit { int pm, pn; };
struct Gemm { const bf16_t* A; const bf16_t* Bt; int M, N, K; };
struct StaticOrder {
    int nM, nN, nwg, G, c;
    DI void init(int M, int N, int G_, int c_) { nM = M / BM; nN = N / BM; nwg = nM * nN; G = G_; c = c_; }
    DI bool next(int i, Unit& u) const {
        const long L = (long)i * G + c; if (L >= nwg) return false;
        int wgid = (int)L; { const int q = nwg / NXCD, r = nwg % NXCD, xcd = wgid % NXCD, off = wgid / NXCD; wgid = (xcd < r ? xcd * (q + 1) : r * (q + 1) + (xcd - r) * q) + off; }
        const int nig = WGM * nN, gid = wgid / nig, fm = gid * WGM, gsz = (nM - fm) < WGM ? (nM - fm) : WGM;
        u.pm = fm + ((wgid % nig) % gsz); u.pn = (wgid % nig) / gsz; return true;
    }
};

template <class Epi>
DI void gemm_phase(LAS unsigned char* lds, const Gemm g, const StaticOrder& S, const Epi& E) {
    const int tid = threadIdx.x, wid = __builtin_amdgcn_readfirstlane(tid >> 6), lane = tid & 63, wr = wid >> 2, wc = wid & 3, fr = lane & 15, fq = lane >> 4;
    const int K = g.K, nt = K / BK;
    unsigned voffA[2], voffB[2];
#pragma unroll
    for (int i = 0; i < 2; ++i) { int R, C; stage_rc(tid * 16 + i * 8192, R, C); const int Rb = (R & ~31) + perm32(R & 31);
        voffA[i] = (unsigned)(R * K + C) * 2u; voffB[i] = (unsigned)(Rb * K + C) * 2u; }
    const size_t kstep = (size_t)(BK * 2);
    const size_t hstep = (size_t)HALF * K * 2;
    const size_t tstep = 2 * hstep;
    const unsigned ldsw = (unsigned)wid * 1024u;
    const int aoff = lds_byte(wr * 64 + fr, fq * 8), boff = lds_byte(wc * 32 + fr, fq * 8);
#define PG8_SA(b, h) (((b) * 2 + (h)) * HTB)
#define PG8_SB(b, h) ((4 + (b) * 2 + (h)) * HTB)
#define PG8_STAGE(bufoff, gbase, voff) do { _Pragma("unroll") for (int _i = 0; _i < 2; ++_i) \
        __builtin_amdgcn_global_load_lds((const unsigned*)((const char*)(gbase) + (voff)[_i]), (LAS unsigned*)(lds + (bufoff) + ldsw + _i * 8192), 16, 0, 0); } while (0)
#define PG8_LDA(dst, b, h) do { _Pragma("unroll") for (int m = 0; m < 4; ++m) _Pragma("unroll") for (int k = 0; k < 2; ++k) dst[m][k] = *(const LAS bf16x8*)(lds + PG8_SA(b, h) + aoff + m * 2048 + k * 1024); } while (0)
#define PG8_LDB(dst, b, h) do { _Pragma("unroll") for (int n = 0; n < 2; ++n) _Pragma("unroll") for (int k = 0; k < 2; ++k) dst[n][k] = *(const LAS bf16x8*)(lds + PG8_SB(b, h) + boff + n * 2048 + k * 1024); } while (0)
#define PG8_MMA(ai, bj, At, Bt) do { __builtin_amdgcn_s_setprio(1); _Pragma("unroll") for (int m = 0; m < 4; ++m) _Pragma("unroll") for (int n = 0; n < 2; ++n) _Pragma("unroll") for (int k = 0; k < 2; ++k) \
        acc[ai][bj][m][n] = __builtin_amdgcn_mfma_f32_16x16x32_bf16(Bt[n][k], At[m][k], acc[ai][bj][m][n], 0, 0, 0); __builtin_amdgcn_s_setprio(0); } while (0)
#define PG8_WAIT_V(n) asm volatile("s_waitcnt vmcnt(" #n ")" ::: "memory")
#define PG8_WAIT_L(n) asm volatile("s_waitcnt lgkmcnt(" #n ")" ::: "memory")
#define PG8_BAR __builtin_amdgcn_s_barrier()
#define PG8_SCHED __builtin_amdgcn_sched_barrier(0)
    Unit cur, nxt; int ui = 0;
    if (!S.next(0, cur)) return;
    f32x4 acc[2][2][4][2];
#pragma unroll
    for (int a = 0; a < 2; ++a)
#pragma unroll
        for (int b = 0; b < 2; ++b)
#pragma unroll
            for (int m = 0; m < 4; ++m)
#pragma unroll
                for (int n = 0; n < 2; ++n) acc[a][b][m][n] = (f32x4){0.f, 0.f, 0.f, 0.f};
    bf16x8 At[4][2], B0[2][2], B1[2][2];
    const char* cA = (const char*)g.A + (size_t)cur.pm * tstep; const char* cB = (const char*)g.Bt + (size_t)cur.pn * tstep;
    PG8_STAGE(PG8_SB(0, 0), cB, voffB); PG8_STAGE(PG8_SA(0, 0), cA, voffA); PG8_STAGE(PG8_SB(0, 1), cB + hstep, voffB); PG8_STAGE(PG8_SA(0, 1), cA + hstep, voffA);
    if (wr == 1) PG8_BAR;
    PG8_WAIT_V(4); PG8_BAR;
    PG8_STAGE(PG8_SB(1, 0), cB + kstep, voffB); PG8_STAGE(PG8_SA(1, 0), cA + kstep, voffA); PG8_STAGE(PG8_SB(1, 1), cB + hstep + kstep, voffB);
    PG8_WAIT_V(6); PG8_BAR;
    for (;;) {
        const bool has_next = S.next(ui + 1, nxt);
        const char* nA = has_next ? (const char*)g.A + (size_t)nxt.pm * tstep : cA; const char* nB = has_next ? (const char*)g.Bt + (size_t)nxt.pn * tstep : cB;
#pragma unroll 1
        for (int t = 0; t < nt; t += 2) {
            const bool last = (t == nt - 2);
            const char* a1 = cA + (size_t)(t + 1) * kstep;
            const char* a2 = last ? nA : cA + (size_t)(t + 2) * kstep; const char* b2 = last ? nB : cB + (size_t)(t + 2) * kstep;
            const char* a3 = a2 + kstep; const char* b3 = b2 + kstep;
            PG8_LDB(B0, 0, 0); PG8_SCHED; PG8_LDA(At, 0, 0); PG8_STAGE(PG8_SA(1, 1), a1 + hstep, voffA);
            PG8_WAIT_L(8); PG8_BAR; PG8_WAIT_L(0); PG8_MMA(0, 0, At, B0); PG8_BAR; PG8_SCHED;
            PG8_LDB(B1, 0, 1); PG8_STAGE(PG8_SB(0, 0), b2, voffB);
            PG8_BAR; PG8_WAIT_L(0); PG8_MMA(0, 1, At, B1); PG8_BAR;
            PG8_LDA(At, 0, 1); PG8_STAGE(PG8_SA(0, 0), a2, voffA);
            PG8_BAR; PG8_WAIT_L(0); PG8_MMA(1, 0, At, B0); PG8_BAR; PG8_SCHED;
            PG8_STAGE(PG8_SB(0, 1), b2 + hstep, voffB);
            PG8_WAIT_V(6); PG8_BAR; PG8_MMA(1, 1, At, B1); PG8_BAR;
            PG8_LDB(B0, 1, 0); PG8_SCHED; PG8_LDA(At, 1, 0); PG8_STAGE(PG8_SA(0, 1), a2 + hstep, voffA);
            PG8_WAIT_L(8); PG8_BAR; PG8_WAIT_L(0); PG8_MMA(0, 0, At, B0); PG8_BAR; PG8_SCHED;
            PG8_LDB(B1, 1, 1); PG8_STAGE(PG8_SB(1, 0), b3, voffB);
            PG8_BAR; PG8_WAIT_L(0); PG8_MMA(0, 1, At, B1); PG8_BAR;
            PG8_LDA(At, 1, 1); PG8_STAGE(PG8_SA(1, 0), a3, voffA);
            PG8_BAR; PG8_WAIT_L(0); PG8_MMA(1, 0, At, B0); PG8_BAR; PG8_SCHED;
            PG8_STAGE(PG8_SB(1, 1), b3 + hstep, voffB);
            PG8_WAIT_V(6); PG8_BAR; PG8_MMA(1, 1, At, B1); PG8_BAR;
        }
        E(acc, cur, wr, wc, fr, fq);
        if (!has_next) break;
#pragma unroll
        for (int a = 0; a < 2; ++a)
#pragma unroll
            for (int b = 0; b < 2; ++b)
#pragma unroll
                for (int m = 0; m < 4; ++m)
#pragma unroll
                    for (int n = 0; n < 2; ++n) acc[a][b][m][n] = (f32x4){0.f, 0.f, 0.f, 0.f};
        cur = nxt; cA = nA; cB = nB; ++ui;
    }
    PG8_WAIT_V(0);
    if (wr == 0) PG8_BAR;
    PG8_BAR;
#undef PG8_SA
#undef PG8_SB
#undef PG8_STAGE
#undef PG8_LDA
#undef PG8_LDB
#undef PG8_MMA
#undef PG8_WAIT_V
#undef PG8_WAIT_L
#undef PG8_BAR
#undef PG8_SCHED
}
}

struct NoPre {};
template <class F> struct EpiT {
    F f;
    DI void operator()(const f32x4 (&acc)[2][2][4][2], const pg8::Unit& u, int wr, int wc, int fr, int fq) const {
#pragma unroll
        for (int ai = 0; ai < 2; ++ai) {
            typename F::Pre pre[4][2];
#pragma unroll
            for (int m = 0; m < 4; ++m)
#pragma unroll
                for (int bj = 0; bj < 2; ++bj) pre[m][bj] = f.load(u.pm * 256 + ai * 128 + wr * 64 + m * 16 + fr, u.pn * 256 + bj * 128 + wc * 32 + 8 * fq);
#pragma unroll
            for (int m = 0; m < 4; ++m)
#pragma unroll
                for (int bj = 0; bj < 2; ++bj) f.apply(u.pm * 256 + ai * 128 + wr * 64 + m * 16 + fr, u.pn * 256 + bj * 128 + wc * 32 + 8 * fq, acc[ai][bj][m][0], acc[ai][bj][m][1], pre[m][bj]);
        }
    }
};
template <class F> DI void run_gemm(LAS unsigned char* lds, const bf16_t* A, const bf16_t* Bt, int M, int N, int K, const F& f, int rot) {
    pg8::Gemm g{A, Bt, M, N, K}; pg8::StaticOrder S; S.init(M, N, (int)gridDim.x, (int)((blockIdx.x + rot) % gridDim.x));
    EpiT<F> E{f};
    pg8::gemm_phase(lds, g, S, E);
}

struct FGemm1 {
    unsigned char* ws; int col0;
    typedef NoPre Pre; DI Pre load(int, int) const { return Pre{}; }
    DI void apply(int row, int gc0, f32x4 a, f32x4 b, const Pre&) const {
        const int gc = gc0 + col0;
        const int pos = row & (SEQ - 1);
        if (gc < 2688) {
            const int m = gc < 1536 ? gc : gc - 1536;
            const int p = m % 96;
            if (p < 24) rope8(a, b, *(const f32x4*)((const float*)(ws + O_COSA) + pos * 12 + (p >> 1)), *(const f32x4*)((const float*)(ws + O_SINA) + pos * 12 + (p >> 1)));
            size_t off;
            if (gc < 1536) off = O_QA + ((size_t)row * 1536 + gc) * 2;
            else { const int seg = m / 384, c = m % 384; off = (seg == 0 ? O_KC : (seg == 1 ? O_KS : O_KW)) + ((size_t)row * 384 + c) * 2; }
            *(u32x4*)(ws + off) = pack8(a, b);
        } else if (gc < 3456) {
            const int m = gc - 2688, seg = m >> 8, c = m & 255;
            const size_t off = (seg == 0 ? O_VC : (seg == 1 ? O_VS : O_VW)) + ((size_t)row * 256 + c) * 2;
            *(u32x4*)(ws + off) = pack8(a, b);
        } else if (gc < 3712) {
            *(u32x4*)(ws + O_CKV + ((size_t)row * 256 + (gc - 3456)) * 2) = pack8(a, b);
            float s = sumsq8(a, b); s += __shfl_xor(s, 16); s += __shfl_xor(s, 32);
            if ((threadIdx.x & 63) < 16) atomicAdd((float*)(ws + O_SSQ) + T + row, s);
        } else if (gc < 3744) {
            const int p = gc - 3712;
            rope8(a, b, *(const f32x4*)((const float*)(ws + O_COSB) + pos * 16 + (p >> 1)), *(const f32x4*)((const float*)(ws + O_SINB) + pos * 16 + (p >> 1)));
            const u32x4 w = pack8(a, b);
            bf16_t* d = (bf16_t*)(ws + O_KMLA) + (size_t)row * 1536 + 64 + p;
            for (int h = 0; h < 16; ++h) *(u32x4*)(d + h * 96) = w;
        } else if (gc < 3792) {
            float* d = (float*)(ws + O_GN) + (size_t)row * 48 + (gc - 3744);
            *(f32x4*)d = (f32x4){sigm(a[0]), sigm(a[1]), sigm(a[2]), sigm(a[3])};
            *(f32x4*)(d + 4) = (f32x4){sigm(b[0]), sigm(b[1]), sigm(b[2]), sigm(b[3])};
        } else if (gc >= 3840) {
            *(u32x4*)(ws + O_CQ + ((size_t)row * 512 + (gc - 3840)) * 2) = pack8(a, b);
            float s = sumsq8(a, b); s += __shfl_xor(s, 16); s += __shfl_xor(s, 32);
            if ((threadIdx.x & 63) < 16) atomicAdd((float*)(ws + O_SSQ) + row, s);
        }
    }
};
struct FMemKV { bf16_t *Km, *Vm;
    typedef NoPre Pre; DI Pre load(int, int) const { return Pre{}; }
    DI void apply(int row, int gc, f32x4 a, f32x4 b, const Pre&) const {
        bf16_t* d = gc < 512 ? Km + (size_t)row * 512 + gc : Vm + (size_t)row * 512 + (gc - 512);
        *(u32x4*)d = pack8(a, b); } };
struct FUq { unsigned char* ws;
    typedef float Pre; DI Pre load(int row, int) const { return ((const float*)(ws + O_SSQ))[row]; }
    DI void apply(int row, int gc, f32x4 a, f32x4 b, const Pre& pre) const {
        const float rs = rsqrtf(pre * (1.f / 512.f) + EPS); a *= rs; b *= rs;
        const int p = gc % 96, pos = row & (SEQ - 1);
        if (p >= 64) rope8(a, b, *(const f32x4*)((const float*)(ws + O_COSB) + pos * 16 + ((p - 64) >> 1)), *(const f32x4*)((const float*)(ws + O_SINB) + pos * 16 + ((p - 64) >> 1)));
        *(u32x4*)(ws + O_QMLA + ((size_t)row * 1536 + gc) * 2) = pack8(a, b); } };
struct FUkv { unsigned char* ws;
    typedef float Pre; DI Pre load(int row, int) const { return ((const float*)(ws + O_SSQ))[T + row]; }
    DI void apply(int row, int gc, f32x4 a, f32x4 b, const Pre& pre) const {
        const float rs = rsqrtf(pre * (1.f / 256.f) + EPS); a *= rs; b *= rs;
        const size_t off = gc < 1024 ? O_KMLA + ((size_t)row * 1536 + (gc >> 6) * 96 + (gc & 63)) * 2 : O_VMLA + ((size_t)row * 1024 + (gc - 1024)) * 2;
        *(u32x4*)(ws + off) = pack8(a, b); } };
struct FGate { bf16_t* g;
    typedef NoPre Pre; DI Pre load(int, int) const { return Pre{}; }
    DI void apply(int row, int gc, f32x4 a, f32x4 b, const Pre&) const {
#pragma unroll
        for (int i = 0; i < 4; ++i) { a[i] = sigm(a[i]); b[i] = sigm(b[i]); }
        *(u32x4*)(g + (size_t)row * 4096 + gc) = pack8(a, b); } };
template <int SECOND> struct FMix { const bf16_t* g; bf16_t* mixed;
    struct Pre { u32x4 g, mx; };
    DI Pre load(int row, int gc) const { Pre p; p.g = *(const u32x4*)(g + (size_t)row * 4096 + SECOND * 2048 + gc); if (SECOND) p.mx = *(const u32x4*)(mixed + (size_t)row * 2048 + gc); return p; }
    DI void apply(int row, int gc, f32x4 a, f32x4 b, const Pre& pre) const {
        f32x4 ga, gb; unpack8(pre.g, ga, gb);
        a *= ga; b *= gb;
        if (SECOND) { f32x4 pa, pb; unpack8(pre.mx, pa, pb); a += pa; b += pb; }
        *(u32x4*)(mixed + (size_t)row * 2048 + gc) = pack8(a, b); } };
template <int MODE> struct FResid { const float* base; float* out; bf16_t* hb; float* ssq;
    struct Pre { f32x4 a, b; u32x4 h; };
    DI Pre load(int row, int gc) const { Pre p;
        if (MODE == 0) { const float* bp = base + (size_t)row * 2048 + gc; p.a = *(const f32x4*)bp; p.b = *(const f32x4*)(bp + 4); }
        else p.h = *(const u32x4*)(hb + (size_t)row * 2048 + gc);
        return p; }
    DI void apply(int row, int gc, f32x4 a, f32x4 b, const Pre& pre) const {
        if (MODE == 0) { a += pre.a; b += pre.b; }
        else { f32x4 pa, pb; unpack8(pre.h, pa, pb); a += pa; b += pb; }
        if (MODE == 2) { float* op = out + (size_t)row * 2048 + gc; *(f32x4*)op = a; *(f32x4*)(op + 4) = b; }
        else *(u32x4*)(hb + (size_t)row * 2048 + gc) = pack8(a, b);
        float s = sumsq8(a, b); s += __shfl_xor(s, 16); s += __shfl_xor(s, 32);
        if ((threadIdx.x & 63) < 16) atomicAdd(ssq + row, s); } };
struct FXq { bf16_t* q; const float* ssq;
    typedef float Pre; DI Pre load(int row, int) const { return ssq[row]; }
    DI void apply(int row, int gc, f32x4 a, f32x4 b, const Pre& pre) const {
        const float rs = rsqrtf(pre * (1.f / 2048.f) + EPS); a *= rs; b *= rs;
        *(u32x4*)(q + (size_t)row * 512 + gc) = pack8(a, b); } };
struct FFf1 { bf16_t* u; const float* ssq;
    typedef float Pre; DI Pre load(int row, int) const { return ssq[row]; }
    DI void apply(int row, int gc, f32x4 a, f32x4 b, const Pre& pre) const {
        const float rs = rsqrtf(pre * (1.f / 2048.f) + EPS);
#pragma unroll
        for (int i = 0; i < 4; ++i) { float z = fmaxf(a[i] * rs, 0.f); a[i] = z * z; z = fmaxf(b[i] * rs, 0.f); b[i] = z * z; }
        *(u32x4*)(u + (size_t)row * 8192 + gc) = pack8(a, b); } };

template <int NMAP> DI int nmap(int n) {
    if (NMAP == 0) return n;
    if (NMAP == 1) {
        if (n < 1536) { const int h = n / 96, p = n % 96; return h * 96 + permNSA(p); }
        if (n < 2688) { const int m = n - 1536, seg = m / 384, c = m % 384, hh = c / 96, p = c % 96; const int sb = seg == 0 ? 1536 : (seg == 1 ? 2176 : 2816); return sb + hh * 96 + permNSA(p); }
        if (n < 3456) { const int m = n - 2688, seg = m >> 8, c = m & 255; const int sb = seg == 0 ? 1920 : (seg == 1 ? 2560 : 3200); return sb + c; }
        if (n < 3712) return 4016 + (n - 3456);
        if (n < 3744) return 4272 + permMLA(n - 3712);
        if (n < 3792) return 3456 + (n - 3744);
        if (n < 3840) return -1;
        return 3504 + (n - 3840);
    }
    if (NMAP == 2) { const int h = n / 96, p = n % 96; return p < 64 ? n : h * 96 + 64 + permMLA(p - 64); }
    return n;
}
template <int KMAP> DI int kmap(int k) { if (KMAP == 1) { const int l = k / 96, p = k % 96; return l * 96 + permNSA(p); } return k; }

template <int NMAP, int KMAP>
DI void transpose_w(const float* __restrict__ src, int ldsrc, int K, bf16_t* __restrict__ dst, int Ndst, const float* __restrict__ kscale, LAS float* tile) {
    const int tn = (Ndst + 63) / 64, tk = K / 64, ntiles = tn * tk;
    if (NMAP == 0 && KMAP == 0) {
        for (int t = blockIdx.x; t < ntiles; t += gridDim.x) {
            const int in = t % tn, ik = t / tn;
#pragma unroll
            for (int i = 0; i < 2; ++i) { const int e = threadIdx.x + i * NTHREADS, kk = e >> 4, n4 = (e & 15) * 4, k = ik * 64 + kk, n = in * 64 + n4;
                f32x4 v = (f32x4){0.f, 0.f, 0.f, 0.f};
                if (n < Ndst) v = *(const f32x4*)(src + (size_t)k * ldsrc + n);
                if (kscale) v *= kscale[k];
                tile[kk * 65 + n4] = v[0]; tile[kk * 65 + n4 + 1] = v[1]; tile[kk * 65 + n4 + 2] = v[2]; tile[kk * 65 + n4 + 3] = v[3]; }
            __syncthreads();
            { const int nn = threadIdx.x >> 3, k8 = (threadIdx.x & 7) * 8, n = in * 64 + nn;
              u32x4 w; w.x = pk2(tile[(k8 + 0) * 65 + nn], tile[(k8 + 1) * 65 + nn]); w.y = pk2(tile[(k8 + 2) * 65 + nn], tile[(k8 + 3) * 65 + nn]);
              w.z = pk2(tile[(k8 + 4) * 65 + nn], tile[(k8 + 5) * 65 + nn]); w.w = pk2(tile[(k8 + 6) * 65 + nn], tile[(k8 + 7) * 65 + nn]);
              if (n < Ndst) *(u32x4*)(dst + (size_t)n * K + ik * 64 + k8) = w; }
            __syncthreads();
        }
        return;
    }
    for (int t = blockIdx.x; t < ntiles; t += gridDim.x) {
        const int in = t % tn, ik = t / tn;
        for (int e = threadIdx.x; e < 4096; e += NTHREADS) {
            const int kk = e >> 6, nn = e & 63, n = in * 64 + nn, k = ik * 64 + kk;
            const int sc = (n < Ndst) ? nmap<NMAP>(n) : -1;
            const int sr = kmap<KMAP>(k);
            float v = (sc >= 0) ? src[(size_t)sr * ldsrc + sc] : 0.f;
            if (kscale) v *= kscale[sr];
            tile[kk * 65 + nn] = v;
        }
        __syncthreads();
        for (int e = threadIdx.x; e < 2048; e += NTHREADS) {
            const int nn = e >> 5, k2 = (e & 31) * 2, n = in * 64 + nn;
            if (n < Ndst) *(unsigned*)(dst + (size_t)n * K + ik * 64 + k2) = pk2(tile[k2 * 65 + nn], tile[(k2 + 1) * 65 + nn]);
        }
        __syncthreads();
    }
}

DI void rmsnorm_rows(const float* __restrict__ src, const float* __restrict__ g, bf16_t* __restrict__ dst, int nrows) {
    const int lane = threadIdx.x & 63, gw = blockIdx.x * (NTHREADS / 64) + (threadIdx.x >> 6), nw = gridDim.x * (NTHREADS / 64);
    for (int row = gw; row < nrows; row += nw) {
        f32x4 v[8]; float ss = 0.f;
#pragma unroll
        for (int i = 0; i < 4; ++i) { const float* sp = src + (size_t)row * 2048 + (i * 64 + lane) * 8; v[2 * i] = *(const f32x4*)sp; v[2 * i + 1] = *(const f32x4*)(sp + 4);
            ss += sumsq8(v[2 * i], v[2 * i + 1]); }
        ss = wave_sum(ss);
        const float rs = rsqrtf(ss * (1.f / 2048.f) + EPS);
#pragma unroll
        for (int i = 0; i < 4; ++i) { const int c0 = (i * 64 + lane) * 8; const f32x4 g0 = *(const f32x4*)(g + c0), g1 = *(const f32x4*)(g + c0 + 4);
            *(u32x4*)(dst + (size_t)row * 2048 + c0) = pack8(v[2 * i] * rs * g0, v[2 * i + 1] * rs * g1); }
    }
}

DI void phase_prep(const Params& p, LAS unsigned char* lds) {
    unsigned char* ws = p.ws;
    LAS float* tile = (LAS float*)lds;
    const int gtid = blockIdx.x * NTHREADS + threadIdx.x, gsz = gridDim.x * NTHREADS;
    { float* z = (float*)(ws + O_SSQ); for (int i = gtid; i < 5 * T; i += gsz) z[i] = 0.f; }
    { float *cA = (float*)(ws + O_COSA), *sA = (float*)(ws + O_SINA), *cB = (float*)(ws + O_COSB), *sB = (float*)(ws + O_SINB);
      for (int i = gtid; i < SEQ * 12; i += gsz) { const int pos = i / 12, j = i % 12; const float inv = 1.0f / powf(500000.0f, (float)(2 * j) / 24.0f); const float ang = (float)pos * inv; cA[i] = cosf(ang); sA[i] = sinf(ang); }
      for (int i = gtid; i < SEQ * 16; i += gsz) { const int pos = i / 16, j = i % 16; const float inv = 1.0f / powf(500000.0f, (float)(2 * j) / 32.0f); const float ang = (float)pos * inv; cB[i] = cosf(ang); sB[i] = sinf(ang); } }
    if (blockIdx.x == 1 % gridDim.x) {
        const int n = threadIdx.x & 127, part = threadIdx.x >> 7;
        float s = 0.f;
        if (n < 96) for (int k = part * 768; k < (part + 1) * 768; ++k) s += p.cmp_pos_k[k] * p.cmp_w1_k[(size_t)k * 96 + n];
        tile[threadIdx.x] = s; __syncthreads();
        if (threadIdx.x < 96) ((float*)(ws + O_BIASK))[threadIdx.x] = tile[threadIdx.x] + tile[threadIdx.x + 128] + tile[threadIdx.x + 256] + tile[threadIdx.x + 384];
        __syncthreads();
        s = 0.f;
        if (n < 64) for (int k = part * 512; k < (part + 1) * 512; ++k) s += p.cmp_pos_v[k] * p.cmp_w1_v[(size_t)k * 64 + n];
        tile[threadIdx.x] = s; __syncthreads();
        if (threadIdx.x < 64) ((float*)(ws + O_BIASK))[96 + threadIdx.x] = tile[threadIdx.x] + tile[threadIdx.x + 128] + tile[threadIdx.x + 256] + tile[threadIdx.x + 384];
        __syncthreads();
    }
    if (blockIdx.x == 2 % gridDim.x) {
        bf16_t* w2k = (bf16_t*)(ws + O_W2K); bf16_t* w2v = (bf16_t*)(ws + O_W2V);
        for (int e = threadIdx.x; e < 96 * 96; e += NTHREADS) { const int n = e / 96, k = e % 96; w2k[e] = f2bf(p.cmp_w2_k[k * 96 + permNSA(n)]); }
        for (int e = threadIdx.x; e < 64 * 64; e += NTHREADS) { const int n = e >> 6, k = e & 63; w2v[e] = f2bf(p.cmp_w2_v[k * 64 + n]); }
    }
    rmsnorm_rows(p.x, p.g_mix, (bf16_t*)(ws + O_XN), T);
    rmsnorm_rows(p.mem, p.g_mem, (bf16_t*)(ws + O_MEMN), BATCH * MEM);
    transpose_w<1, 0>(p.w_in, DIN, 2048, (bf16_t*)(ws + O_WIN), 4352, nullptr, tile);
    transpose_w<0, 0>(p.w_in + 4304, DIN, 2048, (bf16_t*)(ws + O_WG), 4096, nullptr, tile);
    transpose_w<2, 0>(p.mla_w_uq, 1536, 512, (bf16_t*)(ws + O_WUQ), 1536, p.mla_g_q, tile);
    transpose_w<0, 0>(p.mla_w_uk, 1024, 256, (bf16_t*)(ws + O_WUK), 1024, p.mla_g_kv, tile);
    transpose_w<0, 0>(p.mla_w_uv, 1024, 256, (bf16_t*)(ws + O_WUV), 1024, p.mla_g_kv, tile);
    transpose_w<0, 1>(p.cmp_w1_k, 96, 3072, (bf16_t*)(ws + O_W1K), 96, nullptr, tile);
    transpose_w<0, 0>(p.cmp_w1_v, 64, 2048, (bf16_t*)(ws + O_W1V), 64, nullptr, tile);
    transpose_w<0, 0>(p.w_o_nsa, 2048, 1024, (bf16_t*)(ws + O_WONA), 2048, nullptr, tile);
    transpose_w<0, 0>(p.w_o_mla, 2048, 1024, (bf16_t*)(ws + O_WONB), 2048, nullptr, tile);
    transpose_w<0, 0>(p.w_out, 2048, 2048, (bf16_t*)(ws + O_WOUT), 2048, nullptr, tile);
    transpose_w<0, 0>(p.xa_wq, 512, 2048, (bf16_t*)(ws + O_WXQ), 512, p.g_xattn, tile);
    transpose_w<0, 0>(p.xa_wkv, 1024, 2048, (bf16_t*)(ws + O_WXKV), 1024, nullptr, tile);
    transpose_w<0, 0>(p.xa_wo, 2048, 512, (bf16_t*)(ws + O_WXO), 2048, nullptr, tile);
    transpose_w<0, 0>(p.w_ff1, 8192, 2048, (bf16_t*)(ws + O_WFF1), 8192, p.g_mlp, tile);
    transpose_w<0, 0>(p.w_ff2, 2048, 8192, (bf16_t*)(ws + O_WFF2), 2048, nullptr, tile);
}

DI float gelu_tanh(float x) { const float u = 0.7978845608028654f * (x + 0.044715f * x * x * x); return 0.5f * x * (1.f + tanhf(u)); }

template <int DH> DI void compress_stage1(const bf16_t* __restrict__ X  , const bf16_t* __restrict__ W1t  , const float* __restrict__ bias, bf16_t* __restrict__ H, int task) {
    constexpr int NB = DH / 16, SPL = DH / 32;
    const int lane = threadIdx.x & 63, fr = lane & 15, fq = lane >> 4;
    const int bg = task >> 5, ct = task & 31, b = bg >> 2, g = bg & 3;
    int c = ct * 16 + fr; if (c > 510) c = 510;
    const bf16_t* arow = X + ((size_t)(b * SEQ + 16 * c) * 4 + g) * DH + 8 * fq;
    const bf16_t* brow = W1t + (size_t)fr * (32 * DH) + 8 * fq;
    f32x4 acc[NB];
#pragma unroll
    for (int n = 0; n < NB; ++n) acc[n] = (f32x4){0.f, 0.f, 0.f, 0.f};
    for (int l = 0; l < 32; ++l) {
#pragma unroll
        for (int s2 = 0; s2 < SPL; ++s2) {
            const bf16x8 a = *(const bf16x8*)(arow + (size_t)l * 4 * DH + s2 * 32);
            const int koff = l * DH + s2 * 32;
#pragma unroll
            for (int n = 0; n < NB; ++n) { const bf16x8 bb = *(const bf16x8*)(brow + (size_t)n * 16 * (32 * DH) + koff);
                acc[n] = __builtin_amdgcn_mfma_f32_16x16x32_bf16(a, bb, acc[n], 0, 0, 0); }
        }
    }
#pragma unroll
    for (int n = 0; n < NB; ++n)
#pragma unroll
        for (int j = 0; j < 4; ++j) { const int cc = ct * 16 + fq * 4 + j, col = n * 16 + fr;
            H[((size_t)(b * 512 + cc) * 4 + g) * DH + col] = f2bf(gelu_tanh(acc[n][j] + bias[col])); }
}
template <int DH> DI void compress_stage2(const bf16_t* __restrict__ H, const bf16_t* __restrict__ W2t  , bf16_t* __restrict__ O, int task) {
    constexpr int NB = DH / 16, KS = DH / 32;
    const int lane = threadIdx.x & 63, fr = lane & 15, fq = lane >> 4;
    const int bg = task >> 5, ct = task & 31, b = bg >> 2, g = bg & 3;
    int c = ct * 16 + fr; if (c > 510) c = 510;
    const bf16_t* arow = H + ((size_t)(b * 512 + c) * 4 + g) * DH + 8 * fq;
    f32x4 acc[NB];
#pragma unroll
    for (int n = 0; n < NB; ++n) acc[n] = (f32x4){0.f, 0.f, 0.f, 0.f};
#pragma unroll
    for (int s = 0; s < KS; ++s) { const bf16x8 a = *(const bf16x8*)(arow + s * 32);
#pragma unroll
        for (int n = 0; n < NB; ++n) { const bf16x8 bb = *(const bf16x8*)(W2t + (size_t)(n * 16 + fr) * DH + s * 32 + 8 * fq);
            acc[n] = __builtin_amdgcn_mfma_f32_16x16x32_bf16(a, bb, acc[n], 0, 0, 0); } }
#pragma unroll
    for (int n = 0; n < NB; ++n)
#pragma unroll
        for (int j = 0; j < 4; ++j) { const int cc = ct * 16 + fq * 4 + j, col = n * 16 + fr;
            O[((size_t)(b * 512 + cc) * 4 + g) * DH + col] = (cc > 510) ? (bf16_t)0 : f2bf(acc[n][j]); }
}

template <int DK, int DV> struct ALay {
    static constexpr int KSB = DK * 2 + 16, VSB = DV * 2 + 64;
    static constexpr int KBYTES = 64 * KSB, VBYTES = 64 * VSB, BUF = KBYTES + VBYTES;
    static constexpr int NPK = 64 * DK / 8, NPV = 64 * DV / 8;
    static constexpr int KI = (NPK + NTHREADS - 1) / NTHREADS, VI = (NPV + NTHREADS - 1) / NTHREADS;
};
constexpr int IMPS = 129;
constexpr int LDS_IMP = 77824, LDS_UNI = 77824 + 64 * 129 * 4 + 256;

template <int DK, int DV>
DI void tile_load(const bf16_t* __restrict__ Kt, int kstride, const bf16_t* __restrict__ Vt, int vstride, u32x4 (&kr)[ALay<DK, DV>::KI], u32x4 (&vr)[ALay<DK, DV>::VI]) {
    using L = ALay<DK, DV>;
#pragma unroll
    for (int i = 0; i < L::KI; ++i) { const int pi = threadIdx.x + i * NTHREADS; if (pi < L::NPK) { const int row = pi / (DK / 8), ch = pi % (DK / 8); kr[i] = *(const u32x4*)(Kt + (size_t)row * kstride + ch * 8); } }
#pragma unroll
    for (int i = 0; i < L::VI; ++i) { const int pi = threadIdx.x + i * NTHREADS; if (pi < L::NPV) { const int row = pi / (DV / 8), ch = pi % (DV / 8); vr[i] = *(const u32x4*)(Vt + (size_t)row * vstride + ch * 8); } }
}
template <int DK, int DV>
DI void tile_store(LAS unsigned char* kb, const u32x4 (&kr)[ALay<DK, DV>::KI], const u32x4 (&vr)[ALay<DK, DV>::VI]) {
    using L = ALay<DK, DV>;
#pragma unroll
    for (int i = 0; i < L::KI; ++i) { const int pi = threadIdx.x + i * NTHREADS; if (pi < L::NPK) { const int row = pi / (DK / 8), ch = pi % (DK / 8); *(LAS u32x4*)(kb + row * L::KSB + ch * 16) = kr[i]; } }
#pragma unroll
    for (int i = 0; i < L::VI; ++i) { const int pi = threadIdx.x + i * NTHREADS; if (pi < L::NPV) { const int row = pi / (DV / 8), ch = pi % (DV / 8); *(LAS u32x4*)(kb + L::KBYTES + row * L::VSB + ch * 16) = vr[i]; } }
}

struct AttnIn {
    const bf16_t* q;
    const bf16_t *K, *V;
    int kstride, vstride;
    int jlo, jhi;
    int t;
    int tw_lo, tw_hi;
    float sc;
    unsigned long long sel_lo, sel_hi;
    unsigned long long wsel_lo, wsel_hi;
    int tt;
};

template <int MODE> DI bool key_ok(int key, int t) {
    if (MODE == 0 || MODE == 3) return key <= t;
    if (MODE == 1) return key <= t && key >= t - 511;
    if (MODE == 2) return 16 * key + 31 <= t;
    return true;
}

template <int DK, int DV>
DI void tile_pv(LAS unsigned char* kb, const f32x16& S0, const f32x16& S1, f32x16 (&O)[DV / 32]) {
    using L = ALay<DK, DV>;
    const int lane = threadIdx.x & 63, h = lane >> 5, i16 = lane & 15, q4 = i16 >> 2, p4 = i16 & 3, g16 = lane >> 4;
    LAS unsigned char* vb_ = kb + L::KBYTES;
    __builtin_amdgcn_s_setprio(1);
#pragma unroll
    for (int kb2 = 0; kb2 < 2; ++kb2)
#pragma unroll
        for (int s2 = 0; s2 < 2; ++s2) {
            u32x4 pw;
            if (kb2 == 0) { pw.x = pk2(S0[8 * s2 + 0], S0[8 * s2 + 1]); pw.y = pk2(S0[8 * s2 + 2], S0[8 * s2 + 3]); pw.z = pk2(S0[8 * s2 + 4], S0[8 * s2 + 5]); pw.w = pk2(S0[8 * s2 + 6], S0[8 * s2 + 7]); }
            else          { pw.x = pk2(S1[8 * s2 + 0], S1[8 * s2 + 1]); pw.y = pk2(S1[8 * s2 + 2], S1[8 * s2 + 3]); pw.z = pk2(S1[8 * s2 + 4], S1[8 * s2 + 5]); pw.w = pk2(S1[8 * s2 + 6], S1[8 * s2 + 7]); }
            const bf16x8 pb = __builtin_bit_cast(bf16x8, pw);
            const int vrow = 32 * kb2 + 16 * s2 + 4 * h + q4;
#pragma unroll
            for (int d = 0; d < DV / 32; ++d) {
                const int vcol = d * 32 + 16 * (g16 & 1) + 4 * p4;
                const s16x4 lo = __builtin_amdgcn_ds_read_tr16_b64_v4i16((LAS s16x4*)(vb_ + vrow * L::VSB + vcol * 2));
                const s16x4 hi = __builtin_amdgcn_ds_read_tr16_b64_v4i16((LAS s16x4*)(vb_ + (vrow + 8) * L::VSB + vcol * 2));
                bf16x8 va; va[0] = lo[0]; va[1] = lo[1]; va[2] = lo[2]; va[3] = lo[3]; va[4] = hi[0]; va[5] = hi[1]; va[6] = hi[2]; va[7] = hi[3];
                O[d] = __builtin_amdgcn_mfma_f32_32x32x16_bf16(va, pb, O[d], 0, 0, 0);
            }
        }
    __builtin_amdgcn_s_setprio(0);
}

template <int DK, int DV>
DI void tile_qk(LAS unsigned char* kb, const bf16x8 (&qf)[DK / 16], f32x16& S0, f32x16& S1) {
    using L = ALay<DK, DV>;
    const int lane = threadIdx.x & 63, r = lane & 31, h = lane >> 5;
    const f32x16 z16 = {0.f, 0.f, 0.f, 0.f, 0.f, 0.f, 0.f, 0.f, 0.f, 0.f, 0.f, 0.f, 0.f, 0.f, 0.f, 0.f};
    __builtin_amdgcn_s_setprio(1);
#pragma unroll
    for (int s = 0; s < DK / 16; ++s) {
        const bf16x8 a0 = *(const LAS bf16x8*)(kb + r * L::KSB + (16 * s + 8 * h) * 2);
        const bf16x8 a1 = *(const LAS bf16x8*)(kb + (32 + r) * L::KSB + (16 * s + 8 * h) * 2);
        S0 = __builtin_amdgcn_mfma_f32_32x32x16_bf16(a0, qf[s], s == 0 ? z16 : S0, 0, 0, 0);
        S1 = __builtin_amdgcn_mfma_f32_32x32x16_bf16(a1, qf[s], s == 0 ? z16 : S1, 0, 0, 0);
    }
    __builtin_amdgcn_s_setprio(0);
}
template <int DK, int DV, int MODE, int PASS, bool FULL>
DI void tile_smpv(LAS unsigned char* lds, LAS unsigned char* kb, const AttnIn& in, int j, f32x16& S0, f32x16& S1, f32x16 (&O)[DV / 32], float& m, float& l, float inv_l) {
    const int lane = threadIdx.x & 63, h = lane >> 5;
    const int key0 = j * 64;
    const unsigned long long selw = (j < 64) ? in.sel_lo : in.sel_hi;
    const bool rowsel = (MODE == 3) ? ((selw >> (j & 63)) & 1ull) : true;
    if (FULL && PASS == 0) {
        float mx = fmaxf(S0[0], S1[0]);
#pragma unroll
        for (int i = 1; i < 16; ++i) mx = fmaxf(mx, fmaxf(S0[i], S1[i]));
        const float rb = (MODE == 3 && !rowsel) ? -1e30f : 0.f;
        mx = mx * in.sc + rb;
        mx = fmaxf(mx, __shfl_xor(mx, 32));
        if (__any(mx - m > 8.0f)) {
            const float mn = fmaxf(m, mx);
            const float alpha = ex2(m - mn);
            m = mn;
            l *= alpha;
#pragma unroll
            for (int d = 0; d < DV / 32; ++d) O[d] *= alpha;
        }
        const float off = rb - m;
        float ls = 0.f;
#pragma unroll
        for (int i = 0; i < 16; ++i) { const float p0 = ex2(__builtin_fmaf(S0[i], in.sc, off)), p1 = ex2(__builtin_fmaf(S1[i], in.sc, off)); S0[i] = p0; S1[i] = p1; ls += p0 + p1; }
        l += ls;
        tile_pv<DK, DV>(kb, S0, S1, O);
        return;
    }
    int thr = 63, lo = 0;
    if (MODE == 0 || MODE == 3) thr = in.t - key0 - 4 * h;
    if (MODE == 1) { thr = in.t - key0 - 4 * h; lo = thr - 511; }
    if (MODE == 2) thr = ((in.t - 31) >> 4) - key0 - 4 * h;
    if (MODE == 3 && !rowsel) thr = -1;
#define VOK(c) (FULL || (MODE == 4) || (((c) <= thr) && (MODE != 1 || (c) >= lo)))
    if (PASS != 2) {
        float mx = -1e30f;
#pragma unroll
        for (int i = 0; i < 16; ++i) { const int c = 8 * (i >> 2) + (i & 3); S0[i] *= in.sc; S1[i] *= in.sc;
            mx = fmaxf(mx, VOK(c) ? S0[i] : -1e30f); mx = fmaxf(mx, VOK(c + 32) ? S1[i] : -1e30f); }
        mx = fmaxf(mx, __shfl_xor(mx, 32));
        const float mn = fmaxf(m, mx);
        const float alpha = ex2(m - mn);
        m = mn;
        float ls = 0.f;
#pragma unroll
        for (int i = 0; i < 16; ++i) { const int c = 8 * (i >> 2) + (i & 3);
            const float p0 = VOK(c) ? ex2(S0[i] - mn) : 0.f; const float p1 = VOK(c + 32) ? ex2(S1[i] - mn) : 0.f;
            S0[i] = p0; S1[i] = p1; ls += p0 + p1; }
        l = l * alpha + ls;
        if (PASS == 0) {
#pragma unroll
            for (int d = 0; d < DV / 32; ++d) O[d] *= alpha;
        }
    } else {
#pragma unroll
        for (int i = 0; i < 16; ++i) { const int c = 8 * (i >> 2) + (i & 3);
            const float p0 = VOK(c) ? ex2(S0[i] * in.sc - m) * inv_l : 0.f; const float p1 = VOK(c + 32) ? ex2(S1[i] * in.sc - m) * inv_l : 0.f;
            S0[i] = p0; S1[i] = p1; }
#undef VOK
        LAS unsigned* imp = (LAS unsigned*)(lds + LDS_IMP) + in.tt * IMPS;
#pragma unroll
        for (int kb2 = 0; kb2 < 2; ++kb2)
#pragma unroll
            for (int g4 = 0; g4 < 4; ++g4) {
                const float e0 = kb2 ? S1[4 * g4] : S0[4 * g4], e1 = kb2 ? S1[4 * g4 + 1] : S0[4 * g4 + 1], e2 = kb2 ? S1[4 * g4 + 2] : S0[4 * g4 + 2], e3 = kb2 ? S1[4 * g4 + 3] : S0[4 * g4 + 3];
                const int js = (key0 >> 2) + 8 * kb2 + 2 * g4 + h;
                const unsigned wm = (unsigned)((e0 + e1 + e2 + 0.5f * e3) * 536870912.f + 0.5f);
                const unsigned wh = (unsigned)(0.5f * e3 * 536870912.f + 0.5f);
                if (wm != 0u) __hip_atomic_fetch_add(imp + js, wm, __ATOMIC_RELAXED, __HIP_MEMORY_SCOPE_WORKGROUP);
                if (wh != 0u && js + 1 < 128) __hip_atomic_fetch_add(imp + js + 1, wh, __ATOMIC_RELAXED, __HIP_MEMORY_SCOPE_WORKGROUP);
            }
    }
    if (PASS != 1) tile_pv<DK, DV>(kb, S0, S1, O);
}

DI void lds_barrier() { asm volatile("s_waitcnt lgkmcnt(0)" ::: "memory"); __builtin_amdgcn_s_barrier(); asm volatile("" ::: "memory"); }
template <int MODE> DI void tile_flags(const AttnIn& in, int j, bool& wave_on, bool& full) {
    const int key0 = j * 64;
    wave_on = true; full = false;
    if (MODE == 0 || MODE == 3) { wave_on = key0 <= in.tw_hi; full = key0 + 63 <= in.tw_lo; }
    if (MODE == 3) wave_on = wave_on && ((((j < 64) ? in.wsel_lo : in.wsel_hi) >> (j & 63)) & 1ull);
    if (MODE == 1) { wave_on = (key0 <= in.tw_hi) && (key0 + 63 >= in.tw_lo - 511); full = (key0 + 63 <= in.tw_lo) && (key0 >= in.tw_hi - 511); }
    if (MODE == 2) { wave_on = 16 * key0 + 31 <= in.tw_hi; full = 16 * (key0 + 63) + 31 <= in.tw_lo; }
    if (MODE == 4) full = true;
}
template <int DK, int DV, int MODE, int PASS>
DI void smpv_dispatch(LAS unsigned char* lds, LAS unsigned char* kb, const AttnIn& in, int j, f32x16& S0, f32x16& S1, f32x16 (&O)[DV / 32], float& m, float& l, float inv_l) {
    bool wave_on, full; tile_flags<MODE>(in, j, wave_on, full);
    if (!wave_on) return;
    if (PASS == 0 && full) tile_smpv<DK, DV, MODE, PASS, true>(lds, kb, in, j, S0, S1, O, m, l, inv_l);
    else tile_smpv<DK, DV, MODE, PASS, false>(lds, kb, in, j, S0, S1, O, m, l, inv_l);
}
template <int DK, int DV, int MODE, int PASS>
DI void attn_stream(LAS unsigned char* lds, const AttnIn& in, const bf16x8 (&qf)[DK / 16], f32x16 (&O)[DV / 32], float& m, float& l) {
    using L = ALay<DK, DV>;
    static_assert(2 * L::BUF <= LDS_IMP, "tile buffers");
    u32x4 kr[L::KI], vr[L::VI];
    int j = in.jlo;
    LAS const unsigned* uni = (LAS const unsigned*)(lds + LDS_UNI);
    auto tile_on = [&](int jj) -> bool { if (MODE == 3) return (uni[jj >> 5] >> (jj & 31)) & 1u; return true; };
    while (j <= in.jhi && !tile_on(j)) ++j;
    if (j > in.jhi) return;
    const float inv_l = (PASS == 2) ? 1.f / fmaxf(l, 1e-30f) : 0.f;
    tile_load<DK, DV>(in.K + (size_t)j * 64 * in.kstride, in.kstride, in.V + (size_t)j * 64 * in.vstride, in.vstride, kr, vr);
    tile_store<DK, DV>(lds, kr, vr);
    __syncthreads();
    int cur = 0;
    f32x16 S0, S1;
    for (;;) {
        int jn = j + 1;
        while (jn <= in.jhi && !tile_on(jn)) ++jn;
        const bool has_next = jn <= in.jhi;
        if (has_next) tile_load<DK, DV>(in.K + (size_t)jn * 64 * in.kstride, in.kstride, in.V + (size_t)jn * 64 * in.vstride, in.vstride, kr, vr);
        LAS unsigned char* kb = lds + cur * L::BUF;
        bool wave_on, full; tile_flags<MODE>(in, j, wave_on, full);
        if (wave_on) {
            tile_qk<DK, DV>(kb, qf, S0, S1);
            if ((PASS == 0 || MODE == 2) && full) tile_smpv<DK, DV, MODE, PASS, true>(lds, kb, in, j, S0, S1, O, m, l, inv_l);
            else tile_smpv<DK, DV, MODE, PASS, false>(lds, kb, in, j, S0, S1, O, m, l, inv_l);
        }
        if (has_next) tile_store<DK, DV>(lds + (cur ^ 1) * L::BUF, kr, vr);
        lds_barrier();
        if (!has_next) break;
        j = jn; cur ^= 1;
    }
}

template <int DK> DI void load_q(const bf16_t* q, bf16x8 (&qf)[DK / 16]) {
    const int h = (threadIdx.x & 63) >> 5;
#pragma unroll
    for (int s = 0; s < DK / 16; ++s) qf[s] = *(const bf16x8*)(q + 16 * s + 8 * h);
}
template <int NV> DI void zeroO(f32x16 (&O)[NV]) {
#pragma unroll
    for (int d = 0; d < NV; ++d)
#pragma unroll
        for (int i = 0; i < 16; ++i) O[d][i] = 0.f;
}

template <int DK, int DV, int MODE>
DI void attn_mha_item(LAS unsigned char* lds, const bf16_t* Q, int qstride, const bf16_t* K, int kstride, const bf16_t* V, int vstride, bf16_t* Out, int ostride, int t0, int jhi, float sc) {
    const int wid = threadIdx.x >> 6, lane = threadIdx.x & 63, r = lane & 31, h = lane >> 5;
    AttnIn in; in.t = t0 + 32 * wid + r; in.tw_lo = t0 + 32 * wid; in.tw_hi = in.tw_lo + 31;
    in.q = Q + (size_t)in.t * qstride; in.K = K; in.V = V; in.kstride = kstride; in.vstride = vstride; in.jlo = 0; in.jhi = jhi; in.sc = sc;
    in.sel_lo = in.sel_hi = 0ull; in.wsel_lo = in.wsel_hi = ~0ull; in.tt = 0;
    bf16x8 qf[DK / 16]; load_q<DK>(in.q, qf);
    f32x16 O[DV / 32]; zeroO(O);
    float m = -1e30f, l = 0.f;
    attn_stream<DK, DV, MODE, 0>(lds, in, qf, O, m, l);
    l += __shfl_xor(l, 32);
    const float inv = 1.f / fmaxf(l, 1e-30f);
    bf16_t* o = Out + (size_t)in.t * ostride;
#pragma unroll
    for (int d = 0; d < DV / 32; ++d)
#pragma unroll
        for (int g4 = 0; g4 < 4; ++g4) { u32x2 w; w.x = pk2(O[d][4 * g4] * inv, O[d][4 * g4 + 1] * inv); w.y = pk2(O[d][4 * g4 + 2] * inv, O[d][4 * g4 + 3] * inv);
            *(u32x2*)(o + d * 32 + 8 * g4 + 4 * h) = w; }
}

template <int BR>
DI void nsa_item(LAS unsigned char* lds, const Params& p, int b, int g, int qt) {
    unsigned char* ws = p.ws;
    const int wid = threadIdx.x >> 6, lane = threadIdx.x & 63, r = lane & 31, h = lane >> 5;
    const int head = (BR == 3) ? 4 * g + (r >> 3) : 4 * g + (wid >> 1), t0 = qt * 64;
    AttnIn in;
    if (BR == 3) { in.tt = 8 * wid + (r & 7); in.tw_lo = t0 + 8 * wid; in.tw_hi = in.tw_lo + 7; }
    else { in.tt = 32 * (wid & 1) + r; in.tw_lo = t0 + 32 * (wid & 1); in.tw_hi = in.tw_lo + 31; }
    in.t = t0 + in.tt; in.wsel_lo = in.wsel_hi = ~0ull;
    const size_t tok = (size_t)b * SEQ + in.t;
    in.q = (const bf16_t*)(ws + O_QA) + (tok * 16 + head) * 96;
    in.sc = 0.10206207261596577f * 1.4426950408889634f;
    in.sel_lo = in.sel_hi = 0ull;
    const float* gnp = (const float*)(ws + O_GN) + tok * 48 + head * 3;
    bf16_t* oacc = (bf16_t*)(ws + O_OACC) + tok * 1024 + head * 64;
    bf16x8 qf[6]; load_q<96>(in.q, qf);
    f32x16 O[2]; zeroO(O);
    float m = -1e30f, l = 0.f;
    if (BR == 1) {
        in.K = (const bf16_t*)(ws + O_KW) + ((size_t)b * SEQ * 4 + g) * 96; in.kstride = 384;
        in.V = (const bf16_t*)(ws + O_VW) + ((size_t)b * SEQ * 4 + g) * 64; in.vstride = 256;
        in.jlo = qt >= 8 ? qt - 8 : 0; in.jhi = qt;
        attn_stream<96, 64, 1, 0>(lds, in, qf, O, m, l);
        l += __shfl_xor(l, 32);
        const float sc = gnp[2] / fmaxf(l, 1e-30f);
#pragma unroll
        for (int d = 0; d < 2; ++d)
#pragma unroll
            for (int g4 = 0; g4 < 4; ++g4) { u32x2 w; w.x = pk2(O[d][4 * g4] * sc, O[d][4 * g4 + 1] * sc); w.y = pk2(O[d][4 * g4 + 2] * sc, O[d][4 * g4 + 3] * sc); *(u32x2*)(oacc + d * 32 + 8 * g4 + 4 * h) = w; }
    }
    if (BR == 2) {
#ifdef DBG_KW
        in.K = (const bf16_t*)(ws + O_KCC) + ((size_t)b * 512 * 4 + g) * 96; in.kstride = 384;
        in.V = (const bf16_t*)(ws + O_VW) + ((size_t)b * SEQ * 4 + g) * 64; in.vstride = 256;
#else
        in.K = (const bf16_t*)(ws + O_KCC) + ((size_t)b * 512 * 4 + g) * 96; in.kstride = 384;
        in.V = (const bf16_t*)(ws + O_VCC) + ((size_t)b * 512 * 4 + g) * 64; in.vstride = 256;
#endif
        in.jlo = 0; in.jhi = ((t0 + 32) >> 4) >> 6;
        LAS unsigned* imp = (LAS unsigned*)(lds + LDS_IMP);
        for (int i = threadIdx.x; i < 64 * IMPS; i += NTHREADS) imp[i] = 0u;
        attn_stream<96, 64, 2, 1>(lds, in, qf, O, m, l);
        l += __shfl_xor(l, 32);
        zeroO(O);
        attn_stream<96, 64, 2, 2>(lds, in, qf, O, m, l);
        const float sc = gnp[0];
#pragma unroll
        for (int d = 0; d < 2; ++d)
#pragma unroll
            for (int g4 = 0; g4 < 4; ++g4) { u32x2* dp = (u32x2*)(oacc + d * 32 + 8 * g4 + 4 * h); const u32x2 hw = *dp;
                u32x2 w; w.x = pk2(bf2f(hw.x & 0xffffu) + O[d][4 * g4] * sc, bf2f(hw.x >> 16) + O[d][4 * g4 + 1] * sc); w.y = pk2(bf2f(hw.y & 0xffffu) + O[d][4 * g4 + 2] * sc, bf2f(hw.y >> 16) + O[d][4 * g4 + 3] * sc); *dp = w; }
#ifndef DBG_NO_IMP
        const int cur = qt;
        u32x4* selp = (u32x4*)(ws + O_SEL);
#pragma unroll 1
        for (int rr = 0; rr < 8; ++rr) {
            const int tt = wid * 8 + rr;
            LAS const unsigned* row = imp + tt * IMPS;
            unsigned long long blo, bhi;
            if (cur < 16) { blo = __ballot(lane <= cur); bhi = 0ull; }
            else {
                const int ja = lane, jb = lane + 64;
                const bool fa = (ja == 0) || (ja == cur) || (ja == cur - 1), fb = (jb == cur) || (jb == cur - 1);
                const unsigned xa = (ja <= cur) ? (fa ? 0xffffffffu : row[ja] + 1u) : 0u, xb = (jb <= cur) ? (fb ? 0xffffffffu : row[jb] + 1u) : 0u;
                unsigned Tk = 0u;
#pragma unroll 1
                for (int bit = 31; bit >= 0; --bit) { const unsigned c = Tk | (1u << bit);
                    const int cnt = __popcll(__ballot(xa >= c)) + __popcll(__ballot(xb >= c)); if (cnt >= 16) Tk = c; }
                const int ngt = __popcll(__ballot(xa > Tk)) + __popcll(__ballot(xb > Tk));
                const int need = 16 - ngt;
                const unsigned long long ta = __ballot(xa == Tk), tb = __ballot(xb == Tk), lt = (1ull << lane) - 1ull;
                const int pa = __popcll(ta & lt), pb = __popcll(ta) + __popcll(tb & lt);
                blo = __ballot(xa > Tk || (xa == Tk && pa < need)); bhi = __ballot(xb > Tk || (xb == Tk && pb < need));
            }
            if (lane == 0) { u32x4 w; w.x = (unsigned)blo; w.y = (unsigned)(blo >> 32); w.z = (unsigned)bhi; w.w = (unsigned)(bhi >> 32);
                selp[((size_t)b * SEQ + t0 + tt) * 4 + g] = w; }
        }
#endif
        __syncthreads();
    }
    if (BR == 3) {
        in.K = (const bf16_t*)(ws + O_KS) + ((size_t)b * SEQ * 4 + g) * 96; in.kstride = 384;
        in.V = (const bf16_t*)(ws + O_VS) + ((size_t)b * SEQ * 4 + g) * 64; in.vstride = 256;
        in.jlo = 0; in.jhi = qt;
        const u32x4 sw = ((const u32x4*)(ws + O_SEL))[tok * 4 + g];
        in.sel_lo = (unsigned long long)sw.x | ((unsigned long long)sw.y << 32); in.sel_hi = (unsigned long long)sw.z | ((unsigned long long)sw.w << 32);
        LAS unsigned* uni = (LAS unsigned*)(lds + LDS_UNI);
        if (threadIdx.x < 4) uni[threadIdx.x] = 0u;
        __syncthreads();
        { unsigned long long wl = in.sel_lo, wh = in.sel_hi;
#pragma unroll
          for (int o = 1; o < 8; o <<= 1) { wl |= __shfl_xor(wl, o); wh |= __shfl_xor(wh, o); }
          in.wsel_lo = __builtin_amdgcn_readfirstlane((unsigned)wl) | ((unsigned long long)__builtin_amdgcn_readfirstlane((unsigned)(wl >> 32)) << 32);
          in.wsel_hi = __builtin_amdgcn_readfirstlane((unsigned)wh) | ((unsigned long long)__builtin_amdgcn_readfirstlane((unsigned)(wh >> 32)) << 32); }
        if ((r >> 3) == 0) {
            __hip_atomic_fetch_or(uni + 0, sw.x, __ATOMIC_RELAXED, __HIP_MEMORY_SCOPE_WORKGROUP); __hip_atomic_fetch_or(uni + 1, sw.y, __ATOMIC_RELAXED, __HIP_MEMORY_SCOPE_WORKGROUP);
            __hip_atomic_fetch_or(uni + 2, sw.z, __ATOMIC_RELAXED, __HIP_MEMORY_SCOPE_WORKGROUP); __hip_atomic_fetch_or(uni + 3, sw.w, __ATOMIC_RELAXED, __HIP_MEMORY_SCOPE_WORKGROUP);
        }
        __syncthreads();
#ifndef DBG_SEL_SKIP
        attn_stream<96, 64, 3, 0>(lds, in, qf, O, m, l);
#endif
        l += __shfl_xor(l, 32);
        const float sc = gnp[1] / fmaxf(l, 1e-30f);
        bf16_t* oa = (bf16_t*)(ws + O_OA) + tok * 1024 + head * 64;
#pragma unroll
        for (int d = 0; d < 2; ++d)
#pragma unroll
            for (int g4 = 0; g4 < 4; ++g4) { const u32x2 hw = *(const u32x2*)(oacc + d * 32 + 8 * g4 + 4 * h);
                u32x2 w; w.x = pk2(bf2f(hw.x & 0xffffu) + O[d][4 * g4] * sc, bf2f(hw.x >> 16) + O[d][4 * g4 + 1] * sc); w.y = pk2(bf2f(hw.y & 0xffffu) + O[d][4 * g4 + 2] * sc, bf2f(hw.y >> 16) + O[d][4 * g4 + 3] * sc);
                *(u32x2*)(oa + d * 32 + 8 * g4 + 4 * h) = w; }
    }
}

DI int snake_rank(int i) { const int G = gridDim.x, b = blockIdx.x; return i * G + ((i & 1) ? (G - 1 - b) : b); }


#define XB_TMO      128
#define XB_XCNT(j)  (256  + 64 * (j))
#define XB_XSUB(j)  (1280 + 64 * (j))
#define XB_XGEN(j)  (2304 + 64 * (j))
#define XB_TOP      3328
#define XB_TOPGEN   3392
#define XB_SPIN_CAP (1u << 18)
DI unsigned xb_ld(unsigned* p)              { return __hip_atomic_load(p, __ATOMIC_RELAXED, __HIP_MEMORY_SCOPE_AGENT); }
DI unsigned xb_add(unsigned* p, unsigned v) { return __hip_atomic_fetch_add(p, v, __ATOMIC_RELAXED, __HIP_MEMORY_SCOPE_AGENT); }
DI unsigned xb_xcc_id() { return (unsigned)__builtin_amdgcn_s_getreg((3 << 11) | 20) & 0xFu; }
#define XB_SPIN(cond, bar) do { unsigned _sp = 0; while (cond) { __builtin_amdgcn_s_sleep(1); \
    if ((++_sp & 255u) == 0u) { if (xb_ld(&(bar)[XB_TMO])) break; if (_sp > XB_SPIN_CAP) { atomicAdd(&(bar)[XB_TMO], 1u); break; } } } } while (0)
struct XcdBarrier { unsigned* bar; unsigned x; volatile LAS unsigned* st; };
DI XcdBarrier xcd_barrier_post(unsigned* bar, volatile LAS unsigned* st) {
    XcdBarrier b; b.bar = bar; b.x = xb_xcc_id(); b.st = st;
    if (threadIdx.x == 0) (void)xb_add(&bar[XB_XCNT(b.x)], 1u);
    return b;
}
DI void xcd_barrier_complete(unsigned* bar, unsigned x, unsigned& nloc, unsigned& nx) {
    const unsigned G = gridDim.x * gridDim.y * gridDim.z;
    unsigned sum, cnt, mine, sp = 0u;
    for (;;) {
        sum = 0u; cnt = 0u; mine = 0u;
#pragma unroll
        for (unsigned j = 0; j < 16; ++j) { const unsigned c = xb_ld(&bar[XB_XCNT(j)]); sum += c; cnt += (c > 0u) ? 1u : 0u; mine = (j == x) ? c : mine; }
        if (sum == G) break;
        __builtin_amdgcn_s_sleep(1);
        if ((++sp & 255u) == 0u) { if (xb_ld(&bar[XB_TMO])) break; if (sp > XB_SPIN_CAP) { atomicAdd(&bar[XB_TMO], 1u); break; } }
    }
    nloc = mine > 0u ? mine : 1u; nx = cnt > 0u ? cnt : 1u;
}
DI void xcd_barrier(const XcdBarrier& b) {
    asm volatile("s_waitcnt vmcnt(0)" ::: "memory");
    __syncthreads();
    if (threadIdx.x == 0) {
        unsigned* bar = b.bar;
        __builtin_amdgcn_s_waitcnt(0);
        unsigned nloc = b.st[0], nx = b.st[1];
        if (nloc == 0u) { xcd_barrier_complete(bar, b.x, nloc, nx); b.st[0] = nloc; b.st[1] = nx; }
        const unsigned old = xb_add(&bar[XB_XSUB(b.x)], 1u);
        const unsigned gen = old / nloc;
        if (old + 1u == (gen + 1u) * nloc) {
            __builtin_amdgcn_fence(__ATOMIC_RELEASE, "agent");
            asm volatile("s_waitcnt vmcnt(0)" ::: "memory");
            const unsigned og = xb_add(&bar[XB_TOP], 1u);
            const unsigned tg = og / nx;
            if (og + 1u == (tg + 1u) * nx) xb_add(&bar[XB_TOPGEN], 1u);
            else XB_SPIN(xb_ld(&bar[XB_TOPGEN]) == tg, bar);
            __builtin_amdgcn_fence(__ATOMIC_ACQUIRE, "agent");
            xb_add(&bar[XB_XGEN(b.x)], 1u);
            asm volatile("s_waitcnt vmcnt(0)" ::: "memory");
        } else {
            XB_SPIN(xb_ld(&bar[XB_XGEN(b.x)]) == gen, bar);
            __builtin_amdgcn_fence(__ATOMIC_ACQUIRE, "agent");
            asm volatile("s_waitcnt vmcnt(0)" ::: "memory");
        }
    }
    __syncthreads();
}

#ifndef PHMASK
#define PHMASK 0xFFFF
#endif
#define PHON(n) ((PHMASK >> (n)) & 1)
__global__ void __launch_bounds__(NTHREADS, 2) fwd_megakernel(Params p_arg) {
    const Params& p = *(const Params*)__builtin_amdgcn_kernarg_segment_ptr();
    extern __shared__ __attribute__((aligned(16))) unsigned char smem[];
    LAS unsigned char* lds = (LAS unsigned char*)smem;
    cg::grid_group grid = cg::this_grid();
    __shared__ uint4 xb_words;
    if (threadIdx.x == 0) xb_words = make_uint4(0u, 0u, 0u, 0u);
    __syncthreads();
    const XcdBarrier xb = xcd_barrier_post((unsigned*)(p_arg.ws + O_BAR), (volatile LAS unsigned*)&xb_words);
    unsigned char* ws = p.ws;
    const int gwave = blockIdx.x * (NTHREADS / 64) + (threadIdx.x >> 6), nwave = gridDim.x * (NTHREADS / 64);
    float* ssq = (float*)(ws + O_SSQ);
    if (PHON(0) && p.ph_lo <= 0 && 0 < p.ph_hi) { phase_prep(p, lds); }
    if (PHON(1) && p.ph_lo <= 1 && 1 < p.ph_hi) { if (1 > p.ph_lo) grid.sync();
            FGemm1 f{ws, 256};
            run_gemm(lds, (const bf16_t*)(ws + O_XN), (const bf16_t*)(ws + O_WIN) + (size_t)256 * 2048, T, 4096, 2048, f, 0);
            FMemKV fm{(bf16_t*)(ws + O_KMEM), (bf16_t*)(ws + O_VMEM)};
            run_gemm(lds, (const bf16_t*)(ws + O_MEMN), (const bf16_t*)(ws + O_WXKV), BATCH * MEM, 1024, 2048, fm, 128);
    }
    if (PHON(2) && p.ph_lo <= 2 && 2 < p.ph_hi) { if (2 > p.ph_lo) xcd_barrier(xb);
#ifndef P2SEL
#define P2SEL 7
#endif
            { FGemm1 f0{ws, 0}; run_gemm(lds, (const bf16_t*)(ws + O_XN), (const bf16_t*)(ws + O_WIN), T, 256, 2048, f0, 128); }
            if (P2SEL & 1) { FUq fq{ws}; run_gemm(lds, (const bf16_t*)(ws + O_CQ), (const bf16_t*)(ws + O_WUQ), T, 1536, 512, fq, 0); }
            if (P2SEL & 2) { FUkv fk{ws}; run_gemm(lds, (const bf16_t*)(ws + O_CKV), (const bf16_t*)(ws + O_WUK), T, 2048, 256, fk, 0); }
#ifndef NO_CMP1
            for (int wt = gwave; wt < 1024; wt += nwave) {
                if (wt < 512) compress_stage1<96>((const bf16_t*)(ws + O_KC), (const bf16_t*)(ws + O_W1K), (const float*)(ws + O_BIASK), (bf16_t*)(ws + O_HK), wt);
                else compress_stage1<64>((const bf16_t*)(ws + O_VC), (const bf16_t*)(ws + O_W1V), (const float*)(ws + O_BIASK) + 96, (bf16_t*)(ws + O_HV), wt - 512);
            }
#endif
    }
    if (PHON(3) && p.ph_lo <= 3 && 3 < p.ph_hi) { if (3 > p.ph_lo) xcd_barrier(xb);
            for (int wt = gwave; wt < 1024; wt += nwave) {
                if (wt < 512) compress_stage2<96>((const bf16_t*)(ws + O_HK), (const bf16_t*)(ws + O_W2K), (bf16_t*)(ws + O_KCC), wt);
                else compress_stage2<64>((const bf16_t*)(ws + O_HV), (const bf16_t*)(ws + O_W2V), (bf16_t*)(ws + O_VCC), wt - 512);
            }
            for (int i = 0;; ++i) { const int rk = snake_rank(i); if (rk >= 2048) break;
                const int qt = 31 - (rk >> 6), bh = rk & 63, b = bh >> 4, hd = bh & 15;
                attn_mha_item<96, 64, 0>(lds, (const bf16_t*)(ws + O_QMLA) + ((size_t)b * SEQ * 16 + hd) * 96, 1536, (const bf16_t*)(ws + O_KMLA) + ((size_t)b * SEQ * 16 + hd) * 96, 1536,
                                         (const bf16_t*)(ws + O_VMLA) + ((size_t)b * SEQ * 16 + hd) * 64, 1024, (bf16_t*)(ws + O_OB) + (size_t)b * SEQ * 1024 + hd * 64, 1024, qt * 256, qt * 4 + 3,
                                         0.10206207261596577f * 1.4426950408889634f); }
#ifndef DBG_NO_NSA
            for (int it = blockIdx.x; it < 2048; it += gridDim.x) { const int qt = it >> 4, bg = it & 15; nsa_item<1>(lds, p, bg >> 2, bg & 3, qt); }
#endif
    }
#ifdef DBG_PROBE
    { grid.sync();
      if (blockIdx.x == 0) {
          unsigned code = 0;
          const bf16_t* bufs[5] = {(const bf16_t*)(ws + O_KC), (const bf16_t*)(ws + O_W1K), (const bf16_t*)(ws + O_HK), (const bf16_t*)(ws + O_W2K), (const bf16_t*)(ws + O_KCC)};
          const int lens[5] = {4 * 1024 * 1024, 96 * 3072, 8192 * 96, 96 * 96, 8192 * 96};
          const int bits[5] = {1, 2, 8, 16, 32};
          LAS unsigned* red = (LAS unsigned*)lds;
          if (threadIdx.x == 0) red[0] = 0u;
          __syncthreads();
          for (int q = 0; q < 5; ++q) { unsigned bad = 0; for (int i = threadIdx.x; i < lens[q]; i += NTHREADS) { if ((bufs[q][i] & 0x7f80u) == 0x7f80u) bad = 1; }
              if (bad) __hip_atomic_fetch_or(red, (unsigned)bits[q], __ATOMIC_RELAXED, __HIP_MEMORY_SCOPE_WORKGROUP); }
          if (threadIdx.x < 160) { const unsigned u = __float_as_uint(((const float*)(ws + O_BIASK))[threadIdx.x]); if ((u & 0x7f800000u) == 0x7f800000u) __hip_atomic_fetch_or(red, 4u, __ATOMIC_RELAXED, __HIP_MEMORY_SCOPE_WORKGROUP); }
          __syncthreads();
          if (threadIdx.x == 0) ((float*)(ws + O_BIASK))[200] = (float)((10 + red[0]) * 100);
          __syncthreads();
      }
    }
#endif
    if (PHON(4) && p.ph_lo <= 4 && 4 < p.ph_hi) { if (4 > p.ph_lo) xcd_barrier(xb);
            for (int i = 0;; ++i) { const int rk = snake_rank(i); if (rk >= 2048) break; const int qt = 127 - (rk >> 4), bg = rk & 15; nsa_item<2>(lds, p, bg >> 2, bg & 3, qt); }
    }
    if (PHON(5) && p.ph_lo <= 5 && 5 < p.ph_hi) { if (5 > p.ph_lo) xcd_barrier(xb);
#ifndef NO_SEL
            for (int i = 0;; ++i) { const int rk = snake_rank(i); if (rk >= 2048) break; const int qt = 127 - (rk >> 4), bg = rk & 15; nsa_item<3>(lds, p, bg >> 2, bg & 3, qt); }
#endif
#ifndef NO_GATE
            FGate fg{(bf16_t*)(ws + O_GATES)};
            run_gemm(lds, (const bf16_t*)(ws + O_XN), (const bf16_t*)(ws + O_WG), T, 4096, 2048, fg, 0);
#endif
    }
    if (PHON(6) && p.ph_lo <= 6 && 6 < p.ph_hi) { if (6 > p.ph_lo) xcd_barrier(xb);
#ifndef DBG_NO_NSA
            FMix<0> fa{(const bf16_t*)(ws + O_GATES), (bf16_t*)(ws + O_MIXED)};
            run_gemm(lds, (const bf16_t*)(ws + O_OA), (const bf16_t*)(ws + O_WONA), T, 2048, 1024, fa, 0);
#endif
            FMix<1> fb{(const bf16_t*)(ws + O_GATES), (bf16_t*)(ws + O_MIXED)};
            run_gemm(lds, (const bf16_t*)(ws + O_OB), (const bf16_t*)(ws + O_WONB), T, 2048, 1024, fb, 0);
    }
    if (PHON(7) && p.ph_lo <= 7 && 7 < p.ph_hi) { if (7 > p.ph_lo) xcd_barrier(xb);
            FResid<0> f{p.x, p.out, (bf16_t*)(ws + O_XN), ssq + 2 * T};
            run_gemm(lds, (const bf16_t*)(ws + O_MIXED), (const bf16_t*)(ws + O_WOUT), T, 2048, 2048, f, 0);
    }
#if defined(DBG_COPY) && DBG_COPY == 2
    { grid.sync();
      const int lane = threadIdx.x & 63;
      for (int row = gwave; row < T; row += nwave) {
          float ss = 0.f;
#pragma unroll
          for (int i = 0; i < 8; ++i) { const size_t o = (size_t)row * 2048 + (i * 64 + lane) * 4; const f32x4 v = *(const f32x4*)(p.x + o); *(f32x4*)(p.out + o) = v;
              u32x2 w; w.x = pk2(v[0], v[1]); w.y = pk2(v[2], v[3]); *(u32x2*)((bf16_t*)(ws + O_XN) + o) = w; ss += v[0]*v[0] + v[1]*v[1] + v[2]*v[2] + v[3]*v[3]; }
          ss = wave_sum(ss);
          if (lane == 0) ssq[DBG_COPY * T + row] = ss;
      }
    }
#endif
    if (PHON(8) && p.ph_lo <= 8 && 8 < p.ph_hi) { if (8 > p.ph_lo) xcd_barrier(xb);
            FXq f{(bf16_t*)(ws + O_QX), ssq + 2 * T};
            run_gemm(lds, (const bf16_t*)(ws + O_XN), (const bf16_t*)(ws + O_WXQ), T, 512, 2048, f, 0);
    }
    if (PHON(9) && p.ph_lo <= 9 && 9 < p.ph_hi) { if (9 > p.ph_lo) xcd_barrier(xb);
            for (int it = blockIdx.x; it < 512; it += gridDim.x) { const int qt = it >> 4, bh = it & 15, b = bh >> 2, hd = bh & 3;
                attn_mha_item<128, 128, 4>(lds, (const bf16_t*)(ws + O_QX) + ((size_t)b * SEQ * 4 + hd) * 128, 512, (const bf16_t*)(ws + O_KMEM) + ((size_t)b * MEM * 4 + hd) * 128, 512,
                                           (const bf16_t*)(ws + O_VMEM) + ((size_t)b * MEM * 4 + hd) * 128, 512, (bf16_t*)(ws + O_OX) + (size_t)b * SEQ * 512 + hd * 128, 512, qt * 256, 3,
                                           0.08838834764831845f * 1.4426950408889634f); }
    }
    if (PHON(10) && p.ph_lo <= 10 && 10 < p.ph_hi) { if (10 > p.ph_lo) xcd_barrier(xb);
            FResid<1> f{nullptr, p.out, (bf16_t*)(ws + O_XN), ssq + 3 * T};
            run_gemm(lds, (const bf16_t*)(ws + O_OX), (const bf16_t*)(ws + O_WXO), T, 2048, 512, f, 0);
    }
#if defined(DBG_COPY) && DBG_COPY == 3
    { grid.sync();
      const int lane = threadIdx.x & 63;
      for (int row = gwave; row < T; row += nwave) {
          float ss = 0.f;
#pragma unroll
          for (int i = 0; i < 8; ++i) { const size_t o = (size_t)row * 2048 + (i * 64 + lane) * 4; const f32x4 v = *(const f32x4*)(p.x + o); *(f32x4*)(p.out + o) = v;
              u32x2 w; w.x = pk2(v[0], v[1]); w.y = pk2(v[2], v[3]); *(u32x2*)((bf16_t*)(ws + O_XN) + o) = w; ss += v[0]*v[0] + v[1]*v[1] + v[2]*v[2] + v[3]*v[3]; }
          ss = wave_sum(ss);
          if (lane == 0) ssq[DBG_COPY * T + row] = ss;
      }
    }
#endif
    if (PHON(11) && p.ph_lo <= 11 && 11 < p.ph_hi) { if (11 > p.ph_lo) xcd_barrier(xb);
            FFf1 f{(bf16_t*)(ws + O_U), ssq + 3 * T};
            run_gemm(lds, (const bf16_t*)(ws + O_XN), (const bf16_t*)(ws + O_WFF1), T, 8192, 2048, f, 0);
    }
    if (PHON(12) && p.ph_lo <= 12 && 12 < p.ph_hi) { if (12 > p.ph_lo) xcd_barrier(xb);
            FResid<1> f{nullptr, p.out, (bf16_t*)(ws + O_XN), ssq + 4 * T};
            run_gemm(lds, (const bf16_t*)(ws + O_U), (const bf16_t*)(ws + O_WFF2), T, 2048, 8192, f, 0);
    }
    if (PHON(13) && p.ph_lo <= 13 && 13 < p.ph_hi) { if (13 > p.ph_lo) xcd_barrier(xb);
            const int lane = threadIdx.x & 63;
            for (int row = gwave; row < T; row += nwave) {
                const float rs = rsqrtf(ssq[4 * T + row] * (1.f / 2048.f) + EPS);
#pragma unroll
                for (int i = 0; i < 4; ++i) { const int c0 = (i * 64 + lane) * 8; float* op = p.out + (size_t)row * 2048 + c0;
                    const u32x4 hw = *(const u32x4*)((const bf16_t*)(ws + O_XN) + (size_t)row * 2048 + c0);
                    f32x4 va, vb; unpack8(hw, va, vb);
                    const f32x4 g0 = *(const f32x4*)(p.g_final + c0), g1 = *(const f32x4*)(p.g_final + c0 + 4);
                    *(f32x4*)op = (f32x4){va[0] * rs * g0[0], va[1] * rs * g0[1], va[2] * rs * g0[2], va[3] * rs * g0[3]};
                    *(f32x4*)(op + 4) = (f32x4){vb[0] * rs * g1[0], vb[1] * rs * g1[1], vb[2] * rs * g1[2], vb[3] * rs * g1[3]}; }
            }
#ifdef DBG_PROBE
            grid.sync(); if (blockIdx.x == 0 && threadIdx.x == 0) p.out[0] = ((const float*)(ws + O_BIASK))[200];
#endif
    }
}

constexpr int NPHASES = 14;
#ifndef MK_MULTI
#define MK_MULTI 0
#endif

extern "C" void kernel_launch(void* const* d_in, const int* in_sizes, int n_in, void* d_out, int out_size, void* d_ws, size_t ws_size, hipStream_t stream) {
    static int grid = 0;
    if (grid == 0) {
        if (n_in != 27 || ws_size < O_END2) { fprintf(stderr, "kernel_launch: unexpected n_in %d / ws %zu (need %zu)\n", n_in, ws_size, (size_t)O_END2); grid = -1; return; }
        int dev = 0, cus = 0, per_cu = 0;
        hipGetDevice(&dev);
        hipDeviceGetAttribute(&cus, hipDeviceAttributeMultiprocessorCount, dev);
        if (hipFuncSetAttribute((const void*)fwd_megakernel, hipFuncAttributeMaxDynamicSharedMemorySize, LDS_BYTES) != hipSuccess) { fprintf(stderr, "kernel_launch: hipFuncSetAttribute failed\n"); grid = -1; return; }
        if (hipOccupancyMaxActiveBlocksPerMultiprocessor(&per_cu, (const void*)fwd_megakernel, NTHREADS, LDS_BYTES) != hipSuccess || per_cu < 1) { fprintf(stderr, "kernel_launch: occupancy query gave %d\n", per_cu); per_cu = 1; }
        (void)hipGetLastError();
        grid = cus * per_cu;
    }
    if (grid < 0) return;
    Params p{};
    const float** pp = (const float**)&p;
    for (int i = 0; i < 27; ++i) pp[i] = (const float*)d_in[i];
    p.out = (float*)d_out; p.ws = (unsigned char*)d_ws;
#if MK_MULTI
    for (int ph = 0; ph < NPHASES; ++ph) {
        p.ph_lo = ph; p.ph_hi = ph + 1;
        hipLaunchKernelGGL(fwd_megakernel, dim3(grid), dim3(NTHREADS), LDS_BYTES, stream, p);
    }
#else
    (void)hipMemsetAsync((char*)d_ws + O_BAR, 0, (size_t)XCD_BAR_WORDS * 4, stream);
    p.ph_lo = 0; p.ph_hi = NPHASES;
    void* args[] = {&p};
    hipError_t e = hipLaunchCooperativeKernel((const void*)fwd_megakernel, dim3(grid), dim3(NTHREADS), args, LDS_BYTES, stream);
    if (e != hipSuccess) fprintf(stderr, "cooperative launch failed: %s (grid %d)\n", hipGetErrorString(e), grid);
#endif
}
```
